# Optimizing an MI355X kernel written in HIP

```python
import numpy as np
import jax
import jax.numpy as jnp
from jax import lax

D_MODEL = 2048
BATCH = 4
SEQ = 2048
DEPTH = 2

HEAD_DIM = 128
ROPE_THETA = 10000.0
NORM_EPS = 1e-6
Q_CHUNK = 64
DENSE_Q_BLOCK = 128
NEG_BIG = -1e30
TINY = 1e-30
D_FF = 5632
N_BRANCHES = 3

MOBA_HEADS = 4
MOBA_BLOCK = 256
MOBA_TOPK = 3

MLA_HEADS = 6
MLA_Q_RANK = 512
MLA_KV_RANK = 256
MLA_NOPE = 128
MLA_ROPE = 64
MLA_V = 128

NSA_HEADS = 6
NSA_KV_GROUPS = 2
NSA_CMP_LEN = 32
NSA_CMP_STRIDE = 16
NSA_CMP_HIDDEN = 256
NSA_SEL_BLOCK = 64
NSA_SEL_TOPK = 16
NSA_WINDOW = 512
FORCE_SCORE = 1e9

MOBA_W = MOBA_HEADS * HEAD_DIM
NSA_Q_W = NSA_HEADS * HEAD_DIM
NSA_KV_W = NSA_KV_GROUPS * HEAD_DIM
MLA_QH_W = MLA_HEADS * (MLA_NOPE + MLA_ROPE)
MLA_KVH_W = MLA_HEADS * (MLA_NOPE + MLA_V)

IN_SPLITS = (
    MOBA_W, MOBA_W, MOBA_W,
    MLA_Q_RANK, MLA_KV_RANK, MLA_ROPE,
    NSA_Q_W,
    NSA_KV_W, NSA_KV_W,
    NSA_KV_W, NSA_KV_W,
    NSA_KV_W, NSA_KV_W,
    NSA_HEADS * 3,
    N_BRANCHES * D_MODEL,
)
IN_COLS = int(sum(IN_SPLITS))
IN_SPLIT_POINTS = [int(v) for v in np.cumsum(IN_SPLITS)[:-1]]

kernel_name = "hybrid_moba_mla_nsa_macaron"


def rmsnorm(x, g):
    xf = x.astype(jnp.float32)
    y = xf * lax.rsqrt(jnp.mean(xf * xf, axis=-1, keepdims=True) + NORM_EPS)
    return (y * g.astype(jnp.float32)).astype(x.dtype)


def swiglu(h, w_gate, w_up, w_down):
    return (jax.nn.silu(h @ w_gate) * (h @ w_up)) @ w_down


def rope_tables(pos, dim):
    inv = 1.0 / (ROPE_THETA ** (jnp.arange(0, dim, 2, dtype=jnp.float32) / dim))
    ang = pos.astype(jnp.float32)[:, None] * inv[None, :]
    ang = jnp.concatenate([ang, ang], axis=-1)
    return jnp.cos(ang), jnp.sin(ang)


def apply_rope(x, cos, sin):
    xf = x.astype(jnp.float32)
    x1, x2 = jnp.split(xf, 2, axis=-1)
    rot = jnp.concatenate([-x2, x1], axis=-1)
    return (xf * cos + rot * sin).astype(x.dtype)


def masked_softmax(s, mask, scale):
    s = jnp.where(mask, s.astype(jnp.float32) * scale, NEG_BIG)
    s = s - jnp.max(s, axis=-1, keepdims=True)
    e = jnp.where(mask, jnp.exp(s), 0.0)
    return e / jnp.maximum(jnp.sum(e, axis=-1, keepdims=True), TINY)


def to_heads(t, n_heads):
    b, s, _ = t.shape
    return t.reshape(b, s, n_heads, -1).transpose(0, 2, 1, 3)


def moba_attention(q, k, v, cos, sin):
    B, H, S, dh = q.shape
    q = apply_rope(q, cos, sin)
    k = apply_rope(k, cos, sin)
    n_blk = -(-S // MOBA_BLOCK)
    pad = n_blk * MOBA_BLOCK - S
    k_pad = jnp.pad(k, ((0, 0), (0, 0), (0, pad), (0, 0)))
    v_pad = jnp.pad(v, ((0, 0), (0, 0), (0, pad), (0, 0)))
    k_blk = k_pad.reshape(B, H, n_blk, MOBA_BLOCK, dh)
    v_blk = v_pad.reshape(B, H, n_blk, MOBA_BLOCK, dh)
    k_mean = jnp.mean(k_blk.astype(jnp.float32), axis=3)
    top = min(MOBA_TOPK, n_blk)
    scale = dh ** -0.5
    b_idx = jnp.arange(B)[:, None, None, None]
    h_idx = jnp.arange(H)[None, :, None, None]
    blk_ids = jnp.arange(n_blk)

    def chunk(c):
        start = c * Q_CHUNK
        t = start + jnp.arange(Q_CHUNK)
        own = start // MOBA_BLOCK
        qc = lax.dynamic_slice_in_dim(q, start, Q_CHUNK, axis=2)
        gate = jnp.einsum('bhqd,bhnd->bhqn', qc.astype(jnp.float32), k_mean)
        gate = jnp.where(blk_ids < own, gate, -jnp.inf)
        _, idx = lax.top_k(gate, top)
        sel_ok = idx < own
        k_sel = k_blk[b_idx, h_idx, idx]
        v_sel = v_blk[b_idx, h_idx, idx]
        s_sel = jnp.einsum('bhqd,bhqnkd->bhqnk', qc, k_sel).reshape(B, H, Q_CHUNK, top * MOBA_BLOCK)
        m_sel = jnp.broadcast_to(sel_ok[..., None], (B, H, Q_CHUNK, top, MOBA_BLOCK)).reshape(
            B, H, Q_CHUNK, top * MOBA_BLOCK)
        k_own = lax.dynamic_slice_in_dim(k_pad, own * MOBA_BLOCK, MOBA_BLOCK, axis=2)
        v_own = lax.dynamic_slice_in_dim(v_pad, own * MOBA_BLOCK, MOBA_BLOCK, axis=2)
        s_own = jnp.einsum('bhqd,bhkd->bhqk', qc, k_own)
        own_pos = own * MOBA_BLOCK + jnp.arange(MOBA_BLOCK)
        m_own = jnp.broadcast_to(own_pos[None, :] <= t[:, None], (B, H, Q_CHUNK, MOBA_BLOCK))
        p = masked_softmax(jnp.concatenate([s_sel, s_own], axis=-1),
                           jnp.concatenate([m_sel, m_own], axis=-1), scale).astype(v.dtype)
        p_sel = p[..., :top * MOBA_BLOCK].reshape(B, H, Q_CHUNK, top, MOBA_BLOCK)
        p_own = p[..., top * MOBA_BLOCK:]
        return (jnp.einsum('bhqnk,bhqnkd->bhqd', p_sel, v_sel)
                + jnp.einsum('bhqk,bhkd->bhqd', p_own, v_own))

    out = lax.map(chunk, jnp.arange(S // Q_CHUNK))
    return out.transpose(1, 0, 3, 2, 4).reshape(B, S, H * dh)


def mla_attention(c_q, c_kv, k_rope, q_norm, w_uq, kv_norm, w_ukv, cos, sin):
    B, S, _ = c_q.shape
    q = (rmsnorm(c_q, q_norm) @ w_uq).reshape(B, S, MLA_HEADS, MLA_NOPE + MLA_ROPE).transpose(0, 2, 1, 3)
    q_nope = q[..., :MLA_NOPE]
    q_rope = apply_rope(q[..., MLA_NOPE:], cos, sin)
    kv = (rmsnorm(c_kv, kv_norm) @ w_ukv).reshape(B, S, MLA_HEADS, MLA_NOPE + MLA_V).transpose(0, 2, 1, 3)
    k_nope = kv[..., :MLA_NOPE]
    v = kv[..., MLA_NOPE:]
    k_rope = apply_rope(k_rope, cos, sin)
    scale = (MLA_NOPE + MLA_ROPE) ** -0.5
    k_pos = jnp.arange(S)

    def block(c):
        start = c * DENSE_Q_BLOCK
        t = start + jnp.arange(DENSE_Q_BLOCK)
        qn = lax.dynamic_slice_in_dim(q_nope, start, DENSE_Q_BLOCK, axis=2)
        qr = lax.dynamic_slice_in_dim(q_rope, start, DENSE_Q_BLOCK, axis=2)
        s = jnp.einsum('bhqd,bhkd->bhqk', qn, k_nope) + jnp.einsum('bhqd,bkd->bhqk', qr, k_rope)
        p = masked_softmax(s, k_pos[None, :] <= t[:, None], scale).astype(v.dtype)
        return jnp.einsum('bhqk,bhkd->bhqd', p, v)

    out = lax.map(block, jnp.arange(S // DENSE_Q_BLOCK))
    return out.transpose(1, 0, 3, 2, 4).reshape(B, S, MLA_HEADS * MLA_V)


def nsa_compress(blocks, pos, w1, w2):
    B, G, N, L, dh = blocks.shape
    flat = (blocks + pos).reshape(B, G, N, L * dh)
    return jax.nn.gelu(flat @ w1) @ w2


def nsa_attention(q, kc, vc, ks, vs, kw, vw, gate_logits,
                  pos_k, w1_k, w2_k, pos_v, w1_v, w2_v, cos, sin):
    B, S, _ = q.shape
    G, R, dh = NSA_KV_GROUPS, NSA_HEADS // NSA_KV_GROUPS, HEAD_DIM
    q = apply_rope(q.reshape(B, S, G, R, dh).transpose(0, 2, 3, 1, 4), cos, sin)

    def kv_heads(t):
        return t.reshape(B, S, G, dh).transpose(0, 2, 1, 3)

    kc, vc, vs, vw = kv_heads(kc), kv_heads(vc), kv_heads(vs), kv_heads(vw)
    ks = apply_rope(kv_heads(ks), cos, sin)
    kw = apply_rope(kv_heads(kw), cos, sin)

    n_cmp = (S - NSA_CMP_LEN) // NSA_CMP_STRIDE + 1
    cmp_idx = np.arange(n_cmp)[:, None] * NSA_CMP_STRIDE + np.arange(NSA_CMP_LEN)[None, :]
    cmp_end = jnp.asarray(cmp_idx[:, -1])
    cos_c, sin_c = rope_tables(cmp_end, dh)
    k_cmp = apply_rope(nsa_compress(kc[:, :, cmp_idx], pos_k, w1_k, w2_k), cos_c, sin_c)
    v_cmp = nsa_compress(vc[:, :, cmp_idx], pos_v, w1_v, w2_v)

    n_sel = S // NSA_SEL_BLOCK
    top = min(NSA_SEL_TOPK, n_sel)
    sel_start = np.arange(n_sel) * NSA_SEL_BLOCK
    overlap = jnp.asarray(((cmp_idx[:, 0][:, None] <= sel_start[None, :] + NSA_SEL_BLOCK - 1)
                           & (cmp_idx[:, -1][:, None] >= sel_start[None, :])).astype(np.float32))
    ks_blk = ks.reshape(B, G, n_sel, NSA_SEL_BLOCK, dh)
    vs_blk = vs.reshape(B, G, n_sel, NSA_SEL_BLOCK, dh)

    kw_pad = jnp.pad(kw, ((0, 0), (0, 0), (NSA_WINDOW, 0), (0, 0)))
    vw_pad = jnp.pad(vw, ((0, 0), (0, 0), (NSA_WINDOW, 0), (0, 0)))

    gates = jax.nn.sigmoid(gate_logits.reshape(B, S, G, R, 3).transpose(0, 2, 3, 1, 4))
    scale = dh ** -0.5
    b_idx = jnp.arange(B)[:, None, None, None]
    g_idx = jnp.arange(G)[None, :, None, None]
    blk_ids = jnp.arange(n_sel)
    win_len = NSA_WINDOW + Q_CHUNK

    def chunk(c):
        start = c * Q_CHUNK
        t = start + jnp.arange(Q_CHUNK)
        qc = lax.dynamic_slice_in_dim(q, start, Q_CHUNK, axis=3)
        s_c = jnp.einsum('bgrqd,bgnd->bgrqn', qc, k_cmp)
        p_c = masked_softmax(s_c, cmp_end[None, :] <= t[:, None], scale)
        o_c = jnp.einsum('bgrqn,bgnd->bgrqd', p_c.astype(v_cmp.dtype), v_cmp)
        imp = jnp.einsum('bgrqn,nj->bgqj', p_c, overlap)
        cur = t // NSA_SEL_BLOCK
        forced = ((blk_ids[None, :] == 0) | (blk_ids[None, :] == cur[:, None])
                  | (blk_ids[None, :] == cur[:, None] - 1))
        imp = jnp.where(forced, FORCE_SCORE, imp)
        imp = jnp.where(blk_ids[None, :] <= cur[:, None], imp, -jnp.inf)
        _, idx = lax.top_k(imp, top)
        k_sel = ks_blk[b_idx, g_idx, idx]
        v_sel = vs_blk[b_idx, g_idx, idx].reshape(B, G, Q_CHUNK, top * NSA_SEL_BLOCK, dh)
        tok = (idx[..., None] * NSA_SEL_BLOCK + jnp.arange(NSA_SEL_BLOCK)).reshape(
            B, G, Q_CHUNK, top * NSA_SEL_BLOCK)
        m_s = (tok <= t[None, None, :, None])[:, :, None]
        s_s = jnp.einsum('bgrqd,bgqnkd->bgrqnk', qc, k_sel).reshape(B, G, R, Q_CHUNK, top * NSA_SEL_BLOCK)
        p_s = masked_softmax(s_s, m_s, scale)
        o_s = jnp.einsum('bgrqm,bgqmd->bgrqd', p_s.astype(v_sel.dtype), v_sel)
        k_win = lax.dynamic_slice_in_dim(kw_pad, start, win_len, axis=2)
        v_win = lax.dynamic_slice_in_dim(vw_pad, start, win_len, axis=2)
        w_pos = start - NSA_WINDOW + jnp.arange(win_len)
        m_w = ((w_pos[None, :] <= t[:, None]) & (w_pos[None, :] > t[:, None] - NSA_WINDOW)
               & (w_pos[None, :] >= 0))
        s_w = jnp.einsum('bgrqd,bgkd->bgrqk', qc, k_win)
        p_w = masked_softmax(s_w, m_w, scale)
        o_w = jnp.einsum('bgrqk,bgkd->bgrqd', p_w.astype(v_win.dtype), v_win)
        g = lax.dynamic_slice_in_dim(gates, start, Q_CHUNK, axis=3)
        return g[..., 0:1] * o_c + g[..., 1:2] * o_s + g[..., 2:3] * o_w

    out = lax.map(chunk, jnp.arange(S // Q_CHUNK))
    return out.transpose(1, 0, 4, 2, 3, 5).reshape(B, S, NSA_HEADS * dh)


def setup_inputs(seed: int = 0) -> dict:
    key = jax.random.key(seed)
    ks = jax.random.split(key, 26)

    def normal(k, shape, scale):
        return jax.random.normal(k, shape, jnp.float32) * scale

    def dense(k, fan_in, fan_out):
        return normal(k, (DEPTH, fan_in, fan_out), fan_in ** -0.5)

    def gain(k, shape):
        return 1.0 + normal(k, shape, 0.02)

    cmp_in = NSA_CMP_LEN * HEAD_DIM
    return {
        "x": normal(ks[0], (BATCH, SEQ, D_MODEL), 1.0),
        "ffn1_norm": gain(ks[1], (DEPTH, D_MODEL)),
        "ffn1_w_gate": dense(ks[2], D_MODEL, D_FF),
        "ffn1_w_up": dense(ks[3], D_MODEL, D_FF),
        "ffn1_w_down": dense(ks[4], D_FF, D_MODEL),
        "mix_norm": gain(ks[5], (DEPTH, D_MODEL)),
        "w_in": dense(ks[6], D_MODEL, IN_COLS),
        "mla_q_norm": gain(ks[7], (DEPTH, MLA_Q_RANK)),
        "mla_w_uq": dense(ks[8], MLA_Q_RANK, MLA_QH_W),
        "mla_kv_norm": gain(ks[9], (DEPTH, MLA_KV_RANK)),
        "mla_w_ukv": dense(ks[10], MLA_KV_RANK, MLA_KVH_W),
        "nsa_cmp_pos_k": normal(ks[11], (DEPTH, NSA_CMP_LEN, HEAD_DIM), 0.1),
        "nsa_cmp_w1_k": dense(ks[12], cmp_in, NSA_CMP_HIDDEN),
        "nsa_cmp_w2_k": dense(ks[13], NSA_CMP_HIDDEN, HEAD_DIM),
        "nsa_cmp_pos_v": normal(ks[14], (DEPTH, NSA_CMP_LEN, HEAD_DIM), 0.1),
        "nsa_cmp_w1_v": dense(ks[15], cmp_in, NSA_CMP_HIDDEN),
        "nsa_cmp_w2_v": dense(ks[16], NSA_CMP_HIDDEN, HEAD_DIM),
        "w_branch_moba": dense(ks[17], MOBA_W, D_MODEL),
        "w_branch_mla": dense(ks[18], MLA_HEADS * MLA_V, D_MODEL),
        "w_branch_nsa": dense(ks[19], NSA_Q_W, D_MODEL),
        "w_out": dense(ks[20], D_MODEL, D_MODEL),
        "ffn2_norm": gain(ks[21], (DEPTH, D_MODEL)),
        "ffn2_w_gate": dense(ks[22], D_MODEL, D_FF),
        "ffn2_w_up": dense(ks[23], D_MODEL, D_FF),
        "ffn2_w_down": dense(ks[24], D_FF, D_MODEL),
        "final_norm": gain(ks[25], (D_MODEL,)),
    }


def reference(x, ffn1_norm, ffn1_w_gate, ffn1_w_up, ffn1_w_down, mix_norm, w_in,
              mla_q_norm, mla_w_uq, mla_kv_norm, mla_w_ukv,
              nsa_cmp_pos_k, nsa_cmp_w1_k, nsa_cmp_w2_k,
              nsa_cmp_pos_v, nsa_cmp_w1_v, nsa_cmp_w2_v,
              w_branch_moba, w_branch_mla, w_branch_nsa, w_out,
              ffn2_norm, ffn2_w_gate, ffn2_w_up, ffn2_w_down, final_norm):
    B, S, D = x.shape
    pos = jnp.arange(S)
    cos_h, sin_h = rope_tables(pos, HEAD_DIM)
    cos_r, sin_r = rope_tables(pos, MLA_ROPE)

    for i in range(DEPTH):
        h = rmsnorm(x, ffn1_norm[i])
        x = x + 0.5 * swiglu(h, ffn1_w_gate[i], ffn1_w_up[i], ffn1_w_down[i])

        h = rmsnorm(x, mix_norm[i])
        z = h @ w_in[i]
        (a_q, a_k, a_v, b_cq, b_ckv, b_kr, c_q, c_kc, c_vc, c_ks, c_vs, c_kw, c_vw,
         c_gate, merge_logits) = jnp.split(z, IN_SPLIT_POINTS, axis=-1)

        y_a = moba_attention(to_heads(a_q, MOBA_HEADS), to_heads(a_k, MOBA_HEADS),
                             to_heads(a_v, MOBA_HEADS), cos_h, sin_h)
        y_b = mla_attention(b_cq, b_ckv, b_kr, mla_q_norm[i], mla_w_uq[i],
                            mla_kv_norm[i], mla_w_ukv[i], cos_r, sin_r)
        y_c = nsa_attention(c_q, c_kc, c_vc, c_ks, c_vs, c_kw, c_vw, c_gate,
                            nsa_cmp_pos_k[i], nsa_cmp_w1_k[i], nsa_cmp_w2_k[i],
                            nsa_cmp_pos_v[i], nsa_cmp_w1_v[i], nsa_cmp_w2_v[i], cos_h, sin_h)

        g = jax.nn.sigmoid(merge_logits.reshape(B, S, N_BRANCHES, D))
        merged = (g[:, :, 0] * (y_a @ w_branch_moba[i])
                  + g[:, :, 1] * (y_b @ w_branch_mla[i])
                  + g[:, :, 2] * (y_c @ w_branch_nsa[i]))
        x = x + merged @ w_out[i]

        h = rmsnorm(x, ffn2_norm[i])
        x = x + 0.5 * swiglu(h, ffn2_w_gate[i], ffn2_w_up[i], ffn2_w_down[i])

    return rmsnorm(x, final_norm)
```

```cpp
#include <hip/hip_runtime.h>
#include <hip/hip_cooperative_groups.h>
#include <cstdint>
#include <cstdio>
namespace cg = cooperative_groups;

#define LAS __attribute__((address_space(3)))
typedef unsigned short bf16_t;
typedef short bf16x8 __attribute__((ext_vector_type(8)));
typedef float f32x4 __attribute__((ext_vector_type(4)));
typedef float f32x2 __attribute__((ext_vector_type(2)));
typedef unsigned u32x4 __attribute__((ext_vector_type(4)));
typedef unsigned u32x2 __attribute__((ext_vector_type(2)));

constexpr int T = 8192, D = 2048, DFF = 5632, SEQ = 2048, NBATCH = 4, DEPTH = 2;
constexpr int IN_COLS = 10834, ZW = 11008;
constexpr int Z_AQ = 0, Z_AK = 512, Z_AV = 1024, Z_CQ = 1536, Z_CKV = 2048, Z_KR = 2304, Z_NQ = 2368, Z_KC = 3136, Z_VC = 3392,
              Z_KS = 3648, Z_VS = 3904, Z_KW = 4160, Z_VW = 4416, Z_GATE = 4672, Z_MERGE = 4736;
constexpr int NWAVES = 8, NTHREADS = 512;
constexpr int LDS_BYTES = 147456;

__device__ __forceinline__ unsigned f2bf(float f) { unsigned u = __builtin_bit_cast(unsigned, f); return (u + 0x7fffu + ((u >> 16) & 1u)) >> 16; }
typedef __bf16 bf16x2_t __attribute__((ext_vector_type(2)));
__device__ __forceinline__ unsigned pk2(float lo, float hi) { const f32x2 v = {lo, hi}; const bf16x2_t h = __builtin_convertvector(v, bf16x2_t); return __builtin_bit_cast(unsigned, h); }
__device__ __forceinline__ float xmax4(float v) { v = fmaxf(v, __shfl_xor(v, 16)); return fmaxf(v, __shfl_xor(v, 32)); }
__device__ __forceinline__ float xsum4(float v) { v += __shfl_xor(v, 16); return v + __shfl_xor(v, 32); }
__device__ __forceinline__ float bf2f(unsigned short b) { return __builtin_bit_cast(float, (unsigned)b << 16); }
__device__ __forceinline__ float wave_sum(float v) {
#pragma unroll
    for (int o = 1; o < 64; o <<= 1) v += __shfl_xor(v, o);
    return v;
}

namespace pg8 {
constexpr int BM = 256, BK = 64, HALF = 128, HTB = HALF * BK * 2, STAGE_BYTES = 8 * HTB, NXCD = 8, WGM = 8;
__host__ __device__ __forceinline__ int lds_byte(int r, int c) { const int st = (r >> 4) * 2 + (c >> 5), rr = r & 15, cc = c & 31, ob = rr * 64 + cc * 2; return st * 1024 + (ob ^ (((ob >> 9) & 1) << 5)); }
__host__ __device__ __forceinline__ void stage_rc(int b, int& R, int& C) { const int st = b / 1024, sb = b % 1024, swz = sb ^ (((sb >> 9) & 1) << 5); R = (st >> 1) * 16 + swz / 64; C = (st & 1) * 32 + (swz % 64) / 2; }
__host__ __device__ __forceinline__ int perm32(int rho) { const int n = rho >> 4, i = rho & 15; return 8 * (i >> 2) + 4 * n + (i & 3); }

struct Unit { int pm, pn; };
struct Gemm { const bf16_t* A; const bf16_t* Bt; int lda, ldb, M, N, K; };

struct StaticOrder {
    int nM, nN, nwg, G, c;
    __device__ void init(int M, int N, int G_, int c_) { nM = M / BM; nN = N / BM; nwg = nM * nN; G = G_; c = c_; }
    __device__ bool next(int i, Unit& u) const {
        const long L = (long)i * G + c; if (L >= nwg) return false;
        int wgid = (int)L; { const int q = nwg / NXCD, r = nwg % NXCD, xcd = wgid % NXCD, off = wgid / NXCD; wgid = (xcd < r ? xcd * (q + 1) : r * (q + 1) + (xcd - r) * q) + off; }
        const int nig = WGM * nN, gid = wgid / nig, fm = gid * WGM, gsz = (nM - fm) < WGM ? (nM - fm) : WGM;
        u.pm = fm + ((wgid % nig) % gsz); u.pn = (wgid % nig) / gsz; return true;
    }
};

template <class Epi>
__device__ __forceinline__ void gemm_phase(LAS unsigned char* lds, const Gemm g, const StaticOrder& S, const Epi E) {
    int tid = threadIdx.x; asm volatile("" : "+v"(tid));
    const int wid = __builtin_amdgcn_readfirstlane(tid >> 6), lane = tid & 63, wr = wid >> 2, wc = wid & 3, fr = lane & 15, fq = lane >> 4;
    const int K = g.K, nt = K / BK;
    unsigned voffA[2], voffB[2];
#pragma unroll
    for (int i = 0; i < 2; ++i) { int R, C; stage_rc(tid * 16 + i * 8192, R, C); const int Rb = (R & ~31) + perm32(R & 31);
        voffA[i] = (unsigned)(R * g.lda + C) * 2u; voffB[i] = (unsigned)(Rb * g.ldb + C) * 2u; }
    const size_t kstep = (size_t)(BK * 2);
    const size_t hstepA = (size_t)HALF * g.lda * 2, hstepB = (size_t)HALF * g.ldb * 2;
    const size_t tstepA = 2 * hstepA, tstepB = 2 * hstepB;
    const unsigned ldsw = (unsigned)wid * 1024u;
    const int aoff = lds_byte(wr * 64 + fr, fq * 8), boff = lds_byte(wc * 32 + fr, fq * 8);
#define PG8_SA(b, h) (((b) * 2 + (h)) * HTB)
#define PG8_SB(b, h) ((4 + (b) * 2 + (h)) * HTB)
#define PG8_STAGE(bufoff, gbase, voff) do { _Pragma("unroll") for (int _i = 0; _i < 2; ++_i) \
        __builtin_amdgcn_global_load_lds((const unsigned*)((const char*)(gbase) + (voff)[_i]), (LAS unsigned*)(lds + (bufoff) + ldsw + _i * 8192), 16, 0, 0); } while (0)
#define PG8_LDA(dst, b, h) do { _Pragma("unroll") for (int m = 0; m < 4; ++m) _Pragma("unroll") for (int k = 0; k < 2; ++k) dst[m][k] = *(const LAS bf16x8*)(lds + PG8_SA(b, h) + aoff + m * 2048 + k * 1024); } while (0)
#define PG8_LDB(dst, b, h) do { _Pragma("unroll") for (int n = 0; n < 2; ++n) _Pragma("unroll") for (int k = 0; k < 2; ++k) dst[n][k] = *(const LAS bf16x8*)(lds + PG8_SB(b, h) + boff + n * 2048 + k * 1024); } while (0)
#define PG8_MMA(ai, bj, At, Bt) do { __builtin_amdgcn_s_setprio(1); _Pragma("unroll") for (int m = 0; m < 4; ++m) _Pragma("unroll") for (int n = 0; n < 2; ++n) _Pragma("unroll") for (int k = 0; k < 2; ++k) \
        acc[ai][bj][m][n] = __builtin_amdgcn_mfma_f32_16x16x32_bf16(Bt[n][k], At[m][k], acc[ai][bj][m][n], 0, 0, 0); __builtin_amdgcn_s_setprio(0); } while (0)
#define PG8_WAIT_V(n) asm volatile("s_waitcnt vmcnt(" #n ")" ::: "memory")
#define PG8_WAIT_L(n) asm volatile("s_waitcnt lgkmcnt(" #n ")" ::: "memory")
#define PG8_BAR __builtin_amdgcn_s_barrier()
#define PG8_SCHED __builtin_amdgcn_sched_barrier(0)
    Unit cur, nxt; int ui = 0;
    if (!S.next(0, cur)) return;
    f32x4 acc[2][2][4][2];
#pragma unroll
    for (int a = 0; a < 2; ++a)
#pragma unroll
        for (int b = 0; b < 2; ++b)
#pragma unroll
            for (int m = 0; m < 4; ++m)
#pragma unroll
                for (int n = 0; n < 2; ++n) acc[a][b][m][n] = (f32x4){0.f, 0.f, 0.f, 0.f};
    bf16x8 At[4][2], B0[2][2], B1[2][2];
    const char* cA = (const char*)g.A + (size_t)cur.pm * tstepA; const char* cB = (const char*)g.Bt + (size_t)cur.pn * tstepB;
    PG8_STAGE(PG8_SB(0, 0), cB, voffB); PG8_STAGE(PG8_SB(0, 1), cB + hstepB, voffB); PG8_STAGE(PG8_SA(0, 0), cA, voffA); PG8_STAGE(PG8_SA(0, 1), cA + hstepA, voffA);
    if (wr == 1) PG8_BAR;
    PG8_WAIT_V(2); PG8_BAR;
    PG8_STAGE(PG8_SB(1, 0), cB + kstep, voffB); PG8_STAGE(PG8_SA(1, 0), cA + kstep, voffA); PG8_STAGE(PG8_SB(1, 1), cB + hstepB + kstep, voffB);
    PG8_WAIT_V(6); PG8_BAR;
    for (;;) {
        const bool has_next = S.next(ui + 1, nxt);
        const char* nA = has_next ? (const char*)g.A + (size_t)nxt.pm * tstepA : cA; const char* nB = has_next ? (const char*)g.Bt + (size_t)nxt.pn * tstepB : cB;
        for (int t = 0; t < nt; t += 2) {
            const bool last = (t == nt - 2);
            const char* a1 = cA + (size_t)(t + 1) * kstep;
            const char* a2 = last ? nA : cA + (size_t)(t + 2) * kstep; const char* b2 = last ? nB : cB + (size_t)(t + 2) * kstep;
            const char* a3 = a2 + kstep; const char* b3 = b2 + kstep;
            if constexpr (Epi::HOOK) { if (t == Epi::HK1 || t == Epi::HK2) { int fr2 = fr, fq2 = fq; asm volatile("" : "+v"(fr2), "+v"(fq2)); E.hook(acc, cur, wr, wc, fr2, fq2, t == Epi::HK1 ? 0 : 1); PG8_SCHED; } }
            PG8_LDB(B0, 0, 0); PG8_LDB(B1, 0, 1); PG8_SCHED; PG8_LDA(At, 0, 0); PG8_STAGE(PG8_SA(1, 1), a1 + hstepA, voffA);
            PG8_WAIT_V(8); PG8_WAIT_L(0); PG8_BAR; PG8_MMA(0, 0, At, B0); PG8_MMA(0, 1, At, B1); PG8_BAR; PG8_SCHED;
            PG8_LDA(At, 0, 1); PG8_STAGE(PG8_SB(0, 0), b2, voffB); PG8_STAGE(PG8_SB(0, 1), b2 + hstepB, voffB); PG8_STAGE(PG8_SA(0, 0), a2, voffA);
            PG8_WAIT_V(8); PG8_WAIT_L(0); PG8_BAR; PG8_MMA(1, 0, At, B0); PG8_MMA(1, 1, At, B1); PG8_BAR; PG8_SCHED;
            PG8_LDB(B0, 1, 0); PG8_LDB(B1, 1, 1); PG8_SCHED; PG8_LDA(At, 1, 0); PG8_STAGE(PG8_SA(0, 1), a2 + hstepA, voffA);
            PG8_WAIT_V(8); PG8_WAIT_L(0); PG8_BAR; PG8_MMA(0, 0, At, B0); PG8_MMA(0, 1, At, B1); PG8_BAR; PG8_SCHED;
            PG8_LDA(At, 1, 1); PG8_STAGE(PG8_SB(1, 0), b3, voffB); PG8_STAGE(PG8_SB(1, 1), b3 + hstepB, voffB); PG8_STAGE(PG8_SA(1, 0), a3, voffA);
            PG8_WAIT_V(8); PG8_WAIT_L(0); PG8_BAR; PG8_MMA(1, 0, At, B0); PG8_MMA(1, 1, At, B1); PG8_BAR; PG8_SCHED;
        }
        if (wr == 0) PG8_BAR;
        { int fr2 = fr, fq2 = fq; asm volatile("" : "+v"(fr2), "+v"(fq2)); E(acc, cur, wr, wc, fr2, fq2, lds); }
        if (!has_next) break;
#pragma unroll
        for (int a = 0; a < 2; ++a)
#pragma unroll
            for (int b = 0; b < 2; ++b)
#pragma unroll
                for (int m = 0; m < 4; ++m)
#pragma unroll
                    for (int n = 0; n < 2; ++n) acc[a][b][m][n] = (f32x4){0.f, 0.f, 0.f, 0.f};
        cur = nxt; cA = nA; cB = nB; ++ui;
        if (wr == 1) PG8_BAR;
    }
    PG8_WAIT_V(0);
    PG8_BAR;
#undef PG8_SA
#undef PG8_SB
#undef PG8_STAGE
#undef PG8_LDA
#undef PG8_LDB
#undef PG8_MMA
#undef PG8_WAIT_V
#undef PG8_WAIT_L
#undef PG8_BAR
#undef PG8_SCHED
}

typedef f32x4 Acc[2][2][4][2];
__device__ __forceinline__ float silu_f(float x) { return x * __builtin_amdgcn_rcpf(1.f + __builtin_amdgcn_exp2f(-1.4426950408889634f * x)); }
__device__ __forceinline__ float sigm_f(float x) { return __builtin_amdgcn_rcpf(1.f + __builtin_amdgcn_exp2f(-1.4426950408889634f * x)); }
__device__ __forceinline__ float gelu_tanh_f(float x) { const float u = 0.7978845608028654f * (x + 0.044715f * x * x * x); return x * __builtin_amdgcn_rcpf(1.f + __builtin_amdgcn_exp2f(-2.8853900817779268f * u)); }

__device__ __forceinline__ float row_rstd(const float* ssp, size_t row) {
    const f32x4 p0 = *(const f32x4*)(ssp + row * 8), p1 = *(const f32x4*)(ssp + row * 8 + 4);
    return __builtin_amdgcn_rsqf((((p0[0] + p0[1]) + (p0[2] + p0[3])) + ((p1[0] + p1[1]) + (p1[2] + p1[3]))) * (1.f / D) + 1e-6f);
}
struct EpiSwiglu {
    static constexpr bool HOOK = false;
    bf16_t* O; int ldo; const float* ssp = nullptr;
    __device__ __forceinline__ void operator()(const Acc& acc, const Unit& u, int wr, int wc, int fr, int fq, LAS unsigned char* ldsb) const {
        const int row0 = u.pm * BM + wr * 64 + fr, col0 = u.pn * HALF + wc * 32 + fq * 8;
#pragma unroll
        for (int ai = 0; ai < 2; ++ai)
#pragma unroll
            for (int m = 0; m < 4; ++m) {
                const float rs = ssp ? row_rstd(ssp, (size_t)(row0 + ai * HALF + m * 16)) : 1.f;
                const f32x4 g0 = acc[ai][0][m][0] * rs, g1 = acc[ai][0][m][1] * rs, u0 = acc[ai][1][m][0] * rs, u1 = acc[ai][1][m][1] * rs;
                u32x4 w;
                w.x = pk2(silu_f(g0[0]) * u0[0], silu_f(g0[1]) * u0[1]); w.y = pk2(silu_f(g0[2]) * u0[2], silu_f(g0[3]) * u0[3]);
                w.z = pk2(silu_f(g1[0]) * u1[0], silu_f(g1[1]) * u1[1]); w.w = pk2(silu_f(g1[2]) * u1[2], silu_f(g1[3]) * u1[3]);
                *(u32x4*)(O + (size_t)(row0 + ai * HALF + m * 16) * ldo + col0) = w;
            }
    }
};
template <bool F32IN, int SC2  , long SSP_OFF  > struct EpiResidual {
    static constexpr bool HOOK = false;
    bf16_t* X; const float* Xin32;
    __device__ __forceinline__ void operator()(const Acc& acc, const Unit& u, int wr, int wc, int fr, int fq, LAS unsigned char* ldsb) const {
        const int row0 = u.pm * BM + wr * 64 + fr, col0 = u.pn * BM + wc * 32 + fq * 8;
        constexpr int ldx = D; constexpr float scale = 0.5f * SC2;
        float* ssp = (float*)((char*)X + SSP_OFF);
        float ss[2][4];
#pragma unroll
        for (int ai = 0; ai < 2; ++ai)
#pragma unroll
            for (int m = 0; m < 4; ++m) ss[ai][m] = 0.f;
#pragma unroll
        for (int ai = 0; ai < 2; ++ai)
#pragma unroll
            for (int m = 0; m < 4; ++m)
#pragma unroll
                for (int bj = 0; bj < 2; ++bj) {
                    const size_t off = (size_t)(row0 + ai * HALF + m * 16) * ldx + col0 + bj * HALF;
                    f32x4 a, b;
                    if (F32IN) { a = *(const f32x4*)(Xin32 + off); b = *(const f32x4*)(Xin32 + off + 4); }
                    else { const u32x4 w = *(const u32x4*)(X + off);
                        a = (f32x4){__builtin_bit_cast(float, w.x << 16), __builtin_bit_cast(float, w.x & 0xffff0000u), __builtin_bit_cast(float, w.y << 16), __builtin_bit_cast(float, w.y & 0xffff0000u)};
                        b = (f32x4){__builtin_bit_cast(float, w.z << 16), __builtin_bit_cast(float, w.z & 0xffff0000u), __builtin_bit_cast(float, w.w << 16), __builtin_bit_cast(float, w.w & 0xffff0000u)}; }
                    a = a + acc[ai][bj][m][0] * scale; b = b + acc[ai][bj][m][1] * scale;
                    u32x4 o; o.x = pk2(a[0], a[1]); o.y = pk2(a[2], a[3]); o.z = pk2(b[0], b[1]); o.w = pk2(b[2], b[3]);
                    *(u32x4*)(X + off) = o;
                    { const float r0 = __builtin_bit_cast(float, o.x << 16), r1 = __builtin_bit_cast(float, o.x & 0xffff0000u), r2 = __builtin_bit_cast(float, o.y << 16), r3 = __builtin_bit_cast(float, o.y & 0xffff0000u),
                                  r4 = __builtin_bit_cast(float, o.z << 16), r5 = __builtin_bit_cast(float, o.z & 0xffff0000u), r6 = __builtin_bit_cast(float, o.w << 16), r7 = __builtin_bit_cast(float, o.w & 0xffff0000u);
                      ss[ai][m] += ((r0 * r0 + r1 * r1) + (r2 * r2 + r3 * r3)) + ((r4 * r4 + r5 * r5) + (r6 * r6 + r7 * r7)); }
                    if (bj == 1 && m == 3) __builtin_amdgcn_sched_barrier(0);
                }
        LAS float* red = (LAS float*)(ldsb + 131072);
        {
#pragma unroll
            for (int ai = 0; ai < 2; ++ai)
#pragma unroll
                for (int m = 0; m < 4; ++m) { float t = ss[ai][m]; t += __shfl_xor(t, 16); t += __shfl_xor(t, 32);
                    if (fq == 0) red[(ai * HALF + wr * 64 + m * 16 + fr) * 4 + wc] = t; }
            asm volatile("s_waitcnt lgkmcnt(0)" ::: "memory"); __builtin_amdgcn_s_barrier(); asm volatile("" ::: "memory");
            const int tl = (wr * 4 + wc) * 64 + fq * 16 + fr;
            if (tl < 256) { const f32x4 q = *(const LAS f32x4*)(red + tl * 4); ssp[(size_t)(u.pm * BM + tl) * 8 + u.pn] = (q[0] + q[1]) + (q[2] + q[3]); }
        }
    }
};
template <int ACT> struct EpiBf16 {
    static constexpr bool HOOK = false;
    bf16_t* O; int ldo, ncols; const float* bias; const float* ssp = nullptr;
    __device__ __forceinline__ void operator()(const Acc& acc, const Unit& u, int wr, int wc, int fr, int fq, LAS unsigned char* ldsb) const {
        const int row0 = u.pm * BM + wr * 64 + fr, col0 = u.pn * BM + wc * 32 + fq * 8;
#pragma unroll
        for (int bj = 0; bj < 2; ++bj) {
            const int col = col0 + bj * HALF; if (col >= ncols) continue;
            f32x4 b0 = {0.f, 0.f, 0.f, 0.f}, b1 = {0.f, 0.f, 0.f, 0.f};
            if (ACT == 1) { b0 = *(const f32x4*)(bias + col); b1 = *(const f32x4*)(bias + col + 4); }
#pragma unroll
            for (int ai = 0; ai < 2; ++ai)
#pragma unroll
                for (int m = 0; m < 4; ++m) {
                    const float rs = ssp ? row_rstd(ssp, (size_t)(row0 + ai * HALF + m * 16)) : 1.f;
                    f32x4 v0 = acc[ai][bj][m][0] * rs + b0, v1 = acc[ai][bj][m][1] * rs + b1;
                    if (ACT == 1) {
#pragma unroll
                        for (int j = 0; j < 4; ++j) { v0[j] = gelu_tanh_f(v0[j]); v1[j] = gelu_tanh_f(v1[j]); }
                    }
                    u32x4 w; w.x = pk2(v0[0], v0[1]); w.y = pk2(v0[2], v0[3]); w.z = pk2(v1[0], v1[1]); w.w = pk2(v1[2], v1[3]);
                    *(u32x4*)(O + (size_t)(row0 + ai * HALF + m * 16) * ldo + col) = w;
                }
        }
    }
};
struct EpiF32 {
    static constexpr bool HOOK = false;
    float* O; int ldo, ncols;
    __device__ __forceinline__ void operator()(const Acc& acc, const Unit& u, int wr, int wc, int fr, int fq, LAS unsigned char* ldsb) const {
        const int row0 = u.pm * BM + wr * 64 + fr, col0 = u.pn * BM + wc * 32 + fq * 8;
#pragma unroll
        for (int bj = 0; bj < 2; ++bj) {
            const int col = col0 + bj * HALF; if (col >= ncols) continue;
#pragma unroll
            for (int ai = 0; ai < 2; ++ai)
#pragma unroll
                for (int m = 0; m < 4; ++m) {
                    float* p = O + (size_t)(row0 + ai * HALF + m * 16) * ldo + col;
                    *(f32x4*)p = acc[ai][bj][m][0]; *(f32x4*)(p + 4) = acc[ai][bj][m][1];
                }
        }
    }
};
template <int MODE> struct EpiMerge {
    static constexpr bool HOOK = false;
    float* buf; bf16_t* Obf; const bf16_t* gate; int ldg;
    __device__ __forceinline__ void operator()(const Acc& acc, const Unit& u, int wr, int wc, int fr, int fq, LAS unsigned char* ldsb) const {
        const int row0 = u.pm * BM + wr * 64 + fr, col0 = u.pn * BM + wc * 32 + fq * 8;
#pragma unroll
        for (int ai = 0; ai < 2; ++ai)
#pragma unroll
            for (int m = 0; m < 4; ++m)
#pragma unroll
                for (int bj = 0; bj < 2; ++bj) {
                    const size_t row = (size_t)(row0 + ai * HALF + m * 16); const int col = col0 + bj * HALF;
                    const u32x4 gw = *(const u32x4*)(gate + row * ldg + col);
                    f32x4 v0 = acc[ai][bj][m][0], v1 = acc[ai][bj][m][1];
                    v0[0] *= sigm_f(__builtin_bit_cast(float, gw.x << 16)); v0[1] *= sigm_f(__builtin_bit_cast(float, gw.x & 0xffff0000u));
                    v0[2] *= sigm_f(__builtin_bit_cast(float, gw.y << 16)); v0[3] *= sigm_f(__builtin_bit_cast(float, gw.y & 0xffff0000u));
                    v1[0] *= sigm_f(__builtin_bit_cast(float, gw.z << 16)); v1[1] *= sigm_f(__builtin_bit_cast(float, gw.z & 0xffff0000u));
                    v1[2] *= sigm_f(__builtin_bit_cast(float, gw.w << 16)); v1[3] *= sigm_f(__builtin_bit_cast(float, gw.w & 0xffff0000u));
                    float* p = buf + row * D + col;
                    if (MODE >= 1) { v0 = v0 + *(f32x4*)p; v1 = v1 + *(f32x4*)(p + 4); }
                    if (MODE <= 1) { *(f32x4*)p = v0; *(f32x4*)(p + 4) = v1; }
                    else { u32x4 w; w.x = pk2(v0[0], v0[1]); w.y = pk2(v0[2], v0[3]); w.z = pk2(v1[0], v1[1]); w.w = pk2(v1[2], v1[3]); *(u32x4*)(Obf + row * D + col) = w; }
                    if (bj == 1) __builtin_amdgcn_sched_barrier(0);
                }
    }
};
struct EpiMergeH {
    static constexpr bool HOOK = true; static constexpr int HK1 = 8, HK2 = 20;
    bf16_t* Obf; const bf16_t* gate; int ldg;
    __device__ __forceinline__ void hook(Acc& acc, const Unit& u, int wr, int wc, int fr, int fq, int which) const {
        const int row0 = u.pm * BM + wr * 64 + fr, col0 = u.pn * BM + wc * 32 + fq * 8;
        const bf16_t* gp = gate + (size_t)which * D;
#pragma unroll
        for (int ai = 0; ai < 2; ++ai)
#pragma unroll
            for (int m = 0; m < 4; ++m)
#pragma unroll
                for (int bj = 0; bj < 2; ++bj) {
                    const size_t row = (size_t)(row0 + ai * HALF + m * 16); const int col = col0 + bj * HALF;
                    const u32x4 n_ = *(const u32x4*)(gp + row * ldg + col), d_ = *(const u32x4*)(gp + row * ldg + col + D);
                    float ln[8], ld[8];
                    ln[0] = __builtin_bit_cast(float, n_.x << 16); ln[1] = __builtin_bit_cast(float, n_.x & 0xffff0000u); ln[2] = __builtin_bit_cast(float, n_.y << 16); ln[3] = __builtin_bit_cast(float, n_.y & 0xffff0000u);
                    ln[4] = __builtin_bit_cast(float, n_.z << 16); ln[5] = __builtin_bit_cast(float, n_.z & 0xffff0000u); ln[6] = __builtin_bit_cast(float, n_.w << 16); ln[7] = __builtin_bit_cast(float, n_.w & 0xffff0000u);
                    ld[0] = __builtin_bit_cast(float, d_.x << 16); ld[1] = __builtin_bit_cast(float, d_.x & 0xffff0000u); ld[2] = __builtin_bit_cast(float, d_.y << 16); ld[3] = __builtin_bit_cast(float, d_.y & 0xffff0000u);
                    ld[4] = __builtin_bit_cast(float, d_.z << 16); ld[5] = __builtin_bit_cast(float, d_.z & 0xffff0000u); ld[6] = __builtin_bit_cast(float, d_.w << 16); ld[7] = __builtin_bit_cast(float, d_.w & 0xffff0000u);
#pragma unroll
                    for (int j = 0; j < 8; ++j) { const float r = (1.f + __builtin_amdgcn_exp2f(-1.4426950408889634f * ld[j])) * __builtin_amdgcn_rcpf(1.f + __builtin_amdgcn_exp2f(-1.4426950408889634f * ln[j]));
                        if (j < 4) acc[ai][bj][m][0][j] *= r; else acc[ai][bj][m][1][j - 4] *= r; }
                    if (bj == 1 && m == 3) __builtin_amdgcn_sched_barrier(0);
                }
    }
    __device__ __forceinline__ void operator()(const Acc& acc, const Unit& u, int wr, int wc, int fr, int fq, LAS unsigned char* ldsb) const {
        const int row0 = u.pm * BM + wr * 64 + fr, col0 = u.pn * BM + wc * 32 + fq * 8;
#pragma unroll
        for (int ai = 0; ai < 2; ++ai)
#pragma unroll
            for (int m = 0; m < 4; ++m)
#pragma unroll
                for (int bj = 0; bj < 2; ++bj) {
                    const size_t row = (size_t)(row0 + ai * HALF + m * 16); const int col = col0 + bj * HALF;
                    const u32x4 gw = *(const u32x4*)(gate + row * ldg + col + 2 * D);
                    f32x4 v0 = acc[ai][bj][m][0], v1 = acc[ai][bj][m][1];
                    v0[0] *= sigm_f(__builtin_bit_cast(float, gw.x << 16)); v0[1] *= sigm_f(__builtin_bit_cast(float, gw.x & 0xffff0000u));
                    v0[2] *= sigm_f(__builtin_bit_cast(float, gw.y << 16)); v0[3] *= sigm_f(__builtin_bit_cast(float, gw.y & 0xffff0000u));
                    v1[0] *= sigm_f(__builtin_bit_cast(float, gw.z << 16)); v1[1] *= sigm_f(__builtin_bit_cast(float, gw.z & 0xffff0000u));
                    v1[2] *= sigm_f(__builtin_bit_cast(float, gw.w << 16)); v1[3] *= sigm_f(__builtin_bit_cast(float, gw.w & 0xffff0000u));
                    u32x4 w; w.x = pk2(v0[0], v0[1]); w.y = pk2(v0[2], v0[3]); w.z = pk2(v1[0], v1[1]); w.w = pk2(v1[2], v1[3]); *(u32x4*)(Obf + row * D + col) = w;
                    if (bj == 1 && m == 3) __builtin_amdgcn_sched_barrier(0);
                }
    }
};
struct EpiCmpFinish {
    static constexpr bool HOOK = false;
    bf16_t* O; const float* part; const float* bias; unsigned* flag; unsigned expect;
    __device__ __forceinline__ void operator()(const Acc& acc, const Unit& u, int wr, int wc, int fr, int fq, LAS unsigned char* ldsb) const {
        while (__hip_atomic_load(flag, __ATOMIC_RELAXED, __HIP_MEMORY_SCOPE_AGENT) < expect) __builtin_amdgcn_s_sleep(2);
        __builtin_amdgcn_fence(__ATOMIC_ACQUIRE, "agent");
        asm volatile("s_waitcnt vmcnt(0)" ::: "memory");
        const int row0 = u.pm * BM + wr * 64 + fr, col0 = u.pn * BM + wc * 32 + fq * 8;
#pragma unroll
        for (int bj = 0; bj < 2; ++bj) {
            const int col = col0 + bj * HALF;
            const f32x4 b0 = *(const f32x4*)(bias + col), b1 = *(const f32x4*)(bias + col + 4);
#pragma unroll
            for (int ai = 0; ai < 2; ++ai)
#pragma unroll
                for (int m = 0; m < 4; ++m) {
                    const size_t off = (size_t)(row0 + ai * HALF + m * 16) * 256 + col;
                    f32x4 v0 = acc[ai][bj][m][0] + b0 + *(const f32x4*)(part + off), v1 = acc[ai][bj][m][1] + b1 + *(const f32x4*)(part + off + 4);
#pragma unroll
                    for (int j = 0; j < 4; ++j) { v0[j] = gelu_tanh_f(v0[j]); v1[j] = gelu_tanh_f(v1[j]); }
                    u32x4 w; w.x = pk2(v0[0], v0[1]); w.y = pk2(v0[2], v0[3]); w.z = pk2(v1[0], v1[1]); w.w = pk2(v1[2], v1[3]);
                    *(u32x4*)(O + off) = w;
                    if (m & 1) __builtin_amdgcn_sched_barrier(0);
                }
        }
    }
};
}

constexpr size_t al256(size_t x) { return (x + 255) & ~(size_t)255; }
constexpr size_t WS_GU1 = 0;
constexpr size_t WS_DN1 = WS_GU1 + (size_t)2 * DFF * D * 2;
constexpr size_t WS_GU2 = WS_DN1 + (size_t)D * DFF * 2;
constexpr size_t WS_DN2 = WS_GU2 + (size_t)2 * DFF * D * 2;
constexpr size_t WS_WIN = WS_DN2 + (size_t)D * DFF * 2;
constexpr size_t WS_UQ  = WS_WIN + (size_t)ZW * D * 2;
constexpr size_t WS_UKV = WS_UQ + (size_t)1280 * 512 * 2;
constexpr size_t WS_W1K = WS_UKV + (size_t)1536 * 256 * 2;
constexpr size_t WS_W1V = WS_W1K + (size_t)256 * 4096 * 2;
constexpr size_t WS_W2K = WS_W1V + (size_t)256 * 4096 * 2;
constexpr size_t WS_W2V = WS_W2K + (size_t)256 * 256 * 2;
constexpr size_t WS_BRA = WS_W2V + (size_t)256 * 256 * 2;
constexpr size_t WS_BRB = WS_BRA + (size_t)D * 512 * 2;
constexpr size_t WS_BRC = WS_BRB + (size_t)D * 768 * 2;
constexpr size_t WS_WO  = WS_BRC + (size_t)D * 768 * 2;
constexpr size_t WS_X   = WS_WO + (size_t)D * D * 2;
constexpr size_t WS_H   = WS_X + (size_t)T * D * 4;
constexpr size_t WS_Z   = WS_H + (size_t)T * D * 2;
constexpr size_t WS_MB  = WS_Z + (size_t)T * ZW * 2;
constexpr size_t WS_CQN = WS_MB + (size_t)T * D * 4;
constexpr size_t WS_CKVN = WS_CQN + (size_t)T * 512 * 2;
constexpr size_t WS_QF  = WS_CKVN + (size_t)T * 256 * 2;
constexpr size_t WS_KVF = WS_QF + (size_t)T * 1152 * 2;
constexpr size_t WS_KCP = WS_KVF + (size_t)T * 1536 * 2;
constexpr size_t WS_VCP = WS_KCP + (size_t)8 * SEQ * 128 * 2;
constexpr size_t WS_H1K = WS_VCP + (size_t)8 * SEQ * 128 * 2 + 8192;
constexpr size_t WS_H1V = WS_H1K + (size_t)1024 * 256 * 2;
constexpr size_t WS_KCMP = WS_H1V + (size_t)1024 * 256 * 2;
constexpr size_t WS_VCMP = WS_KCMP + (size_t)1024 * 128 * 4;
constexpr size_t WS_BPART = WS_VCMP + (size_t)1024 * 128 * 4;
constexpr size_t WS_BIAS = WS_BPART + (size_t)2 * 64 * 256 * 4;
constexpr size_t WS_KMP = WS_BIAS + (size_t)2 * 256 * 4;
constexpr size_t WS_KM  = WS_KMP + (size_t)256 * 512 * 4;
constexpr size_t WS_SELB = WS_KM + (size_t)32 * 512 * 4;
constexpr size_t WS_OC  = WS_SELB + (size_t)8 * SEQ * 4;
constexpr size_t WS_YA  = WS_OC + (size_t)T * 768 * 4;
constexpr size_t WS_YB  = WS_YA + (size_t)T * 512 * 2;
constexpr size_t WS_YC  = WS_YB + (size_t)T * 768 * 2;
constexpr size_t WS_COSH = WS_YC + (size_t)T * 768 * 2;
constexpr size_t WS_SINH = WS_COSH + (size_t)SEQ * 64 * 4;
constexpr size_t WS_COSR = WS_SINH + (size_t)SEQ * 64 * 4;
constexpr size_t WS_SINR = WS_COSR + (size_t)SEQ * 32 * 4;
constexpr size_t WS_BAR = WS_SINR + (size_t)SEQ * 32 * 4;
constexpr size_t WS_H1P = WS_BAR + 256;
constexpr size_t WS_SSP = WS_H1P + (size_t)2 * 1024 * 256 * 4;
constexpr size_t WS_XB = WS_SSP + (size_t)T * 8 * 4;
constexpr size_t WS_END0 = WS_XB + 16384;

__device__ __forceinline__ int conv_row(int kind, int n) {
    if (kind == 1) return ((n >> 7) << 8) + (n & 127);
    if (kind == 2) return ((n >> 7) << 8) + 128 + (n & 127);
    if (kind == 3) return n < 4690 ? n : n + (Z_MERGE - 4690);
    return n;
}
struct ConvDesc { const float* W; bf16_t* WT; const float* gain; int K, N, kind, ldw, koff, k0, n0; };
__device__ __forceinline__ void conv_load(const ConvDesc& d, int wave, int lane, f32x4 (&v)[8]) {
    const int n = d.n0 + 4 * lane;
    const float* src = d.W + (size_t)(d.k0 + wave * 8) * d.N + n;
    if ((d.N & 3) == 0) {
        const bool ok = n < d.N;
#pragma unroll
        for (int r = 0; r < 8; ++r) v[r] = ok ? *(const f32x4*)(src + (size_t)r * d.N) : (f32x4){0.f, 0.f, 0.f, 0.f};
    } else {
#pragma unroll
        for (int r = 0; r < 8; ++r)
#pragma unroll
            for (int e = 0; e < 4; ++e) v[r][e] = (n + e < d.N) ? src[(size_t)r * d.N + e] : 0.f;
    }
    if (d.gain) {
#pragma unroll
        for (int r = 0; r < 8; ++r) v[r] = v[r] * d.gain[d.k0 + wave * 8 + r];
    }
}
__device__ __forceinline__ void conv_lds_write(LAS float* tile, int wave, int lane, const f32x4 (&v)[8]) {
#pragma unroll
    for (int r = 0; r < 8; ++r)
#pragma unroll
        for (int e = 0; e < 4; ++e) tile[(wave * 8 + r) * 257 + 4 * lane + e] = v[r][e];
}
__device__ __forceinline__ void conv_store(const ConvDesc& d, const LAS float* tile, int tid) {
    const int c = tid & 7;
#pragma unroll
    for (int j = 0; j < 4; ++j) { const int nl = (tid >> 3) + 64 * j; const LAS float* s = tile + (8 * c) * 257 + nl;
        u32x4 o; o.x = pk2(s[0 * 257], s[1 * 257]); o.y = pk2(s[2 * 257], s[3 * 257]); o.z = pk2(s[4 * 257], s[5 * 257]); o.w = pk2(s[6 * 257], s[7 * 257]);
        if (d.n0 + nl < d.N) *(u32x4*)(d.WT + (size_t)conv_row(d.kind, d.n0 + nl) * d.ldw + d.koff + d.k0 + 8 * c) = o; }
}
constexpr int conv_items(int K, int N) { return (K / 64) * ((N + 255) / 256); }

struct ConvTab { int idx, K, N, off256, kind, end, ldw, koff; };
constexpr int CI_G = conv_items(D, DFF), CI_D = conv_items(DFF, D), CI_IN = conv_items(D, IN_COLS), CI_UQ = conv_items(512, 1152), CI_UKV = conv_items(256, 1536),
              CI_W1 = conv_items(4096, 256), CI_W2 = conv_items(256, 128), CI_BA = conv_items(512, D), CI_BB = conv_items(768, D), CI_WO = conv_items(D, D);
constexpr int CE0 = CI_G, CE1 = CE0 + CI_G, CE2 = CE1 + CI_D, CE3 = CE2 + CI_G, CE4 = CE3 + CI_G, CE5 = CE4 + CI_D, CE6 = CE5 + CI_IN, CE7 = CE6 + CI_UQ, CE8 = CE7 + CI_UKV,
              CE9 = CE8 + CI_W1, CE10 = CE9 + CI_W1, CE11 = CE10 + CI_W2, CE12 = CE11 + CI_W2, CE13 = CE12 + CI_BA, CE14 = CE13 + CI_BB, CE15 = CE14 + CI_BB, CE16 = CE15 + CI_WO;
constexpr int CONV_NITEMS = CE16;
__constant__ ConvTab CONV_TAB[17] = {
    {2, D, DFF, (int)(WS_GU1 / 256), 1, CE0, D, 0}, {3, D, DFF, (int)(WS_GU1 / 256), 2, CE1, D, 0}, {4, DFF, D, (int)(WS_DN1 / 256), 0, CE2, DFF, 0},
    {22, D, DFF, (int)(WS_GU2 / 256), 1, CE3, D, 0}, {23, D, DFF, (int)(WS_GU2 / 256), 2, CE4, D, 0}, {24, DFF, D, (int)(WS_DN2 / 256), 0, CE5, DFF, 0},
    {6, D, IN_COLS, (int)(WS_WIN / 256), 3, CE6, D, 0}, {8, 512, 1152, (int)(WS_UQ / 256), 0, CE7, 512, 0}, {10, 256, 1536, (int)(WS_UKV / 256), 0, CE8, 256, 0},
    {12, 4096, 256, (int)(WS_W1K / 256), 0, CE9, 4096, 0}, {15, 4096, 256, (int)(WS_W1V / 256), 0, CE10, 4096, 0}, {13, 256, 128, (int)(WS_W2K / 256), 0, CE11, 256, 0}, {16, 256, 128, (int)(WS_W2V / 256), 0, CE12, 256, 0},
    {17, 512, D, (int)(WS_BRA / 256), 0, CE13, 2048, 0}, {18, 768, D, (int)(WS_BRA / 256), 0, CE14, 2048, 512}, {19, 768, D, (int)(WS_BRA / 256), 0, CE15, 2048, 1280}, {20, D, D, (int)(WS_WO / 256), 0, CE16, D, 0}};
static_assert(WS_GU1 % 256 == 0 && WS_DN1 % 256 == 0 && WS_GU2 % 256 == 0 && WS_DN2 % 256 == 0 && WS_WIN % 256 == 0 && WS_UQ % 256 == 0 && WS_UKV % 256 == 0 && WS_W1K % 256 == 0 && WS_W1V % 256 == 0 &&
              WS_W2K % 256 == 0 && WS_W2V % 256 == 0 && WS_BRA % 256 == 0 && WS_BRB % 256 == 0 && WS_BRC % 256 == 0 && WS_WO % 256 == 0, "conversion table offsets");

__device__ __forceinline__ void rms_row_bf16(const float* xrow, const float* g, bf16_t* orow, int lane) {
    const f32x4* xr = (const f32x4*)xrow + lane; const f32x4* gr = (const f32x4*)g + lane;
    f32x4 v[8]; float s = 0.f;
#pragma unroll
    for (int j = 0; j < 8; ++j) { v[j] = xr[64 * j]; s += (v[j].x * v[j].x + v[j].y * v[j].y) + (v[j].z * v[j].z + v[j].w * v[j].w); }
    const float rstd = 1.f / sqrtf(wave_sum(s) * (1.f / D) + 1e-6f);
    u32x2* o8 = (u32x2*)orow + lane;
#pragma unroll
    for (int j = 0; j < 8; ++j) { const f32x4 gg = gr[64 * j]; u32x2 w; w.x = pk2(v[j].x * rstd * gg.x, v[j].y * rstd * gg.y); w.y = pk2(v[j].z * rstd * gg.z, v[j].w * rstd * gg.w); o8[64 * j] = w; }
}
__device__ __forceinline__ float rms_load_bf16row(const bf16_t* xrow, int lane, float (&v)[4][8]) {
    float s = 0.f;
#pragma unroll
    for (int j = 0; j < 4; ++j) { const u32x4 w = *((const u32x4*)xrow + lane + 64 * j);
        v[j][0] = __builtin_bit_cast(float, w.x << 16); v[j][1] = __builtin_bit_cast(float, w.x & 0xffff0000u); v[j][2] = __builtin_bit_cast(float, w.y << 16); v[j][3] = __builtin_bit_cast(float, w.y & 0xffff0000u);
        v[j][4] = __builtin_bit_cast(float, w.z << 16); v[j][5] = __builtin_bit_cast(float, w.z & 0xffff0000u); v[j][6] = __builtin_bit_cast(float, w.w << 16); v[j][7] = __builtin_bit_cast(float, w.w & 0xffff0000u);
#pragma unroll
        for (int i = 0; i < 8; ++i) s += v[j][i] * v[j][i]; }
    return 1.f / sqrtf(wave_sum(s) * (1.f / D) + 1e-6f);
}
__device__ __forceinline__ void rms_xrow_bf16(const bf16_t* xrow, const float* g, bf16_t* orow, int lane) {
    float v[4][8]; const float rstd = rms_load_bf16row(xrow, lane, v);
#pragma unroll
    for (int j = 0; j < 4; ++j) { const float* gp = g + (lane + 64 * j) * 8; const f32x4 g0 = *(const f32x4*)gp, g1 = *(const f32x4*)(gp + 4);
        u32x4 o; o.x = pk2(v[j][0] * rstd * g0[0], v[j][1] * rstd * g0[1]); o.y = pk2(v[j][2] * rstd * g0[2], v[j][3] * rstd * g0[3]);
        o.z = pk2(v[j][4] * rstd * g1[0], v[j][5] * rstd * g1[1]); o.w = pk2(v[j][6] * rstd * g1[2], v[j][7] * rstd * g1[3]);
        *((u32x4*)orow + lane + 64 * j) = o; }
}
__device__ __forceinline__ void rms_xrow_f32(const bf16_t* xrow, const float* g, float* orow, int lane) {
    float v[4][8]; const float rstd = rms_load_bf16row(xrow, lane, v);
#pragma unroll
    for (int j = 0; j < 4; ++j) { const float* gp = g + (lane + 64 * j) * 8; const f32x4 g0 = *(const f32x4*)gp, g1 = *(const f32x4*)(gp + 4); float* op = orow + (lane + 64 * j) * 8;
        *(f32x4*)op = (f32x4){v[j][0] * rstd * g0[0], v[j][1] * rstd * g0[1], v[j][2] * rstd * g0[2], v[j][3] * rstd * g0[3]};
        *(f32x4*)(op + 4) = (f32x4){v[j][4] * rstd * g1[0], v[j][5] * rstd * g1[1], v[j][6] * rstd * g1[2], v[j][7] * rstd * g1[3]}; }
}
__device__ __forceinline__ void rms_row_f32(const float* xrow, const float* g, float* orow, int lane) {
    const f32x4* xr = (const f32x4*)xrow + lane; const f32x4* gr = (const f32x4*)g + lane;
    f32x4 v[8]; float s = 0.f;
#pragma unroll
    for (int j = 0; j < 8; ++j) { v[j] = xr[64 * j]; s += (v[j].x * v[j].x + v[j].y * v[j].y) + (v[j].z * v[j].z + v[j].w * v[j].w); }
    const float rstd = 1.f / sqrtf(wave_sum(s) * (1.f / D) + 1e-6f);
    f32x4* o = (f32x4*)orow + lane;
#pragma unroll
    for (int j = 0; j < 8; ++j) { const f32x4 gg = gr[64 * j]; o[64 * j] = (f32x4){v[j].x * rstd * gg.x, v[j].y * rstd * gg.y, v[j].z * rstd * gg.z, v[j].w * rstd * gg.w}; }
}

namespace att {
typedef short s16x4 __attribute__((ext_vector_type(4)));
constexpr int VS = 272;
constexpr float NEGB = -1e30f;
__device__ __forceinline__ bf16x8 vtr2(LAS unsigned char* p0, LAS unsigned char* p1) {
    const s16x4 a = __builtin_amdgcn_ds_read_tr16_b64_v4i16((LAS s16x4*)p0);
    const s16x4 b = __builtin_amdgcn_ds_read_tr16_b64_v4i16((LAS s16x4*)p1);
    return (bf16x8){a[0], a[1], a[2], a[3], b[0], b[1], b[2], b[3]};
}
__device__ __forceinline__ bf16x8 pack8(const float* v) {
    u32x4 w; w.x = pk2(v[0], v[1]); w.y = pk2(v[2], v[3]); w.z = pk2(v[4], v[5]); w.w = pk2(v[6], v[7]);
    return __builtin_bit_cast(bf16x8, w);
}
__device__ __forceinline__ void unpack8(const u32x4 w, float* v) {
    v[0] = __builtin_bit_cast(float, w.x << 16); v[1] = __builtin_bit_cast(float, w.x & 0xffff0000u);
    v[2] = __builtin_bit_cast(float, w.y << 16); v[3] = __builtin_bit_cast(float, w.y & 0xffff0000u);
    v[4] = __builtin_bit_cast(float, w.z << 16); v[5] = __builtin_bit_cast(float, w.z & 0xffff0000u);
    v[6] = __builtin_bit_cast(float, w.w << 16); v[7] = __builtin_bit_cast(float, w.w & 0xffff0000u);
}

struct Pass {
    const bf16_t* K1; const bf16_t* K2; const bf16_t* V; int ldk1, ldk2, ldv;
    int window, shift; float sc;
};

template <int NSLAB>
__device__ __forceinline__ void load_q(const bf16_t* qrow, int t_seq, int g4, const float* cosT, const float* sinT, float (&qv)[NSLAB][8]) {
#pragma unroll
    for (int s = 0; s < NSLAB; ++s) { const u32x4 w = *(const u32x4*)(qrow + s * 32 + g4 * 8); unpack8(w, qv[s]); }
    if (NSLAB == 4) {
#pragma unroll
        for (int s = 0; s < 2; ++s) {
            const float* cp = cosT + (size_t)t_seq * 64 + s * 32 + g4 * 8; const float* sp = sinT + (size_t)t_seq * 64 + s * 32 + g4 * 8;
            const f32x4 c0 = *(const f32x4*)cp, c1 = *(const f32x4*)(cp + 4), s0 = *(const f32x4*)sp, s1 = *(const f32x4*)(sp + 4);
#pragma unroll
            for (int i = 0; i < 8; ++i) { const float c = i < 4 ? c0[i & 3] : c1[i & 3], sn = i < 4 ? s0[i & 3] : s1[i & 3];
                const float lo = qv[s][i], hi = qv[s + 2][i]; qv[s][i] = lo * c - hi * sn; qv[s + 2][i] = hi * c + lo * sn; }
        }
    } else {
        const float* cp = cosT + (size_t)t_seq * 32 + g4 * 8; const float* sp = sinT + (size_t)t_seq * 32 + g4 * 8;
        const f32x4 c0 = *(const f32x4*)cp, c1 = *(const f32x4*)(cp + 4), s0 = *(const f32x4*)sp, s1 = *(const f32x4*)(sp + 4);
#pragma unroll
        for (int i = 0; i < 8; ++i) { const float c = i < 4 ? c0[i & 3] : c1[i & 3], sn = i < 4 ? s0[i & 3] : s1[i & 3];
            const float lo = qv[NSLAB - 2][i], hi = qv[NSLAB - 1][i]; qv[NSLAB - 2][i] = lo * c - hi * sn; qv[NSLAB - 1][i] = hi * c + lo * sn; }
    }
}

template <int NSLAB>
__device__ __forceinline__ void attn_tile(LAS unsigned char* Kb, int kb, bool nomask, int window, int shift, float sc, const bf16x8 (&qf)[NSLAB], unsigned bits, int t,
                                          f32x4 (&o)[8], float& m, float& l, int r16, int g4, int q4, int p4) {
    constexpr int KS = NSLAB * 64 + 16, VOFF = 64 * KS;
    constexpr int VB = NSLAB == 4 ? 4 : 2;
    LAS unsigned char* kbase = Kb + r16 * KS + g4 * 16;
    LAS unsigned char* vbase = Kb + VOFF + (g4 * 4 + q4) * VS + (4 * p4) * 2;
#define AT_SB __builtin_amdgcn_sched_barrier(0)
#define AT_RDK(dst, sub) do { _Pragma("unroll") for (int sl = 0; sl < NSLAB; ++sl) dst[sl] = *(const LAS bf16x8*)(kbase + (sub) * 16 * KS + sl * 64); } while (0)
#define AT_MMK(src, sub) do { s[sub] = (f32x4){0.f, 0.f, 0.f, 0.f}; __builtin_amdgcn_s_setprio(1); _Pragma("unroll") for (int sl = 0; sl < NSLAB; ++sl) s[sub] = __builtin_amdgcn_mfma_f32_16x16x32_bf16(src[sl], qf[sl], s[sub], 0, 0, 0); __builtin_amdgcn_s_setprio(0); } while (0)
#define AT_RDV(dst, dt0) do { _Pragma("unroll") for (int d = 0; d < VB; ++d) _Pragma("unroll") for (int s2 = 0; s2 < 2; ++s2) { LAS unsigned char* vp = vbase + s2 * 32 * VS + ((dt0) + d) * 32; dst[d * 2 + s2] = vtr2(vp, vp + 16 * VS); } } while (0)
#define AT_MMV(src, dt0) do { __builtin_amdgcn_s_setprio(1); _Pragma("unroll") for (int d = 0; d < VB; ++d) _Pragma("unroll") for (int s2 = 0; s2 < 2; ++s2) o[(dt0) + d] = __builtin_amdgcn_mfma_f32_16x16x32_bf16(src[d * 2 + s2], pf[s2], o[(dt0) + d], 0, 0, 0); __builtin_amdgcn_s_setprio(0); } while (0)
    f32x4 s[4];
    bf16x8 ka[NSLAB], kc[NSLAB], va[VB * 2], vb[VB * 2];
    AT_RDK(ka, 0); AT_SB;
    AT_RDK(kc, 1); AT_MMK(ka, 0); AT_SB;
    AT_RDK(ka, 2); AT_MMK(kc, 1); AT_SB;
    AT_RDK(kc, 3); AT_MMK(ka, 2); AT_SB;
    AT_RDV(va, 0); AT_MMK(kc, 3); AT_SB;
    float mx = NEGB;
    if (nomask) {
        const bool sel = ((bits >> (kb >> shift)) & 1u) != 0u;
        const float scm = sel ? sc : 0.f, bias = sel ? 0.f : NEGB;
#pragma unroll
        for (int sub = 0; sub < 4; ++sub)
#pragma unroll
            for (int j = 0; j < 4; ++j) { const float v = fmaf(s[sub][j], scm, bias); s[sub][j] = v; mx = fmaxf(mx, v); }
    } else {
        const bool sel = ((bits >> (kb >> shift)) & 1u) != 0u;
        const float scm = sel ? sc : 0.f, bias = sel ? 0.f : NEGB;
        const int rel = t - kb - g4 * 4, lo = rel - window;
#pragma unroll
        for (int sub = 0; sub < 4; ++sub)
#pragma unroll
            for (int j = 0; j < 4; ++j) { const int c = sub * 16 + j;
                const bool ok = (c <= rel) && (c > lo);
                const float v = ok ? fmaf(s[sub][j], scm, bias) : NEGB; s[sub][j] = v; mx = fmaxf(mx, v); }
    }
    mx = xmax4(mx);
    const float mn = fmaxf(m, mx), alpha = __builtin_amdgcn_exp2f(m - mn); m = mn;
    const float mne = fmaxf(mn, -1e20f);
    float ls = 0.f;
#pragma unroll
    for (int sub = 0; sub < 4; ++sub)
#pragma unroll
        for (int j = 0; j < 4; ++j) { const float p = __builtin_amdgcn_exp2f(s[sub][j] - mne); s[sub][j] = p; ls += p; }
    l = l * alpha + ls;
    if (__any(alpha != 1.f)) {
#pragma unroll
        for (int dt = 0; dt < 8; ++dt) o[dt] = o[dt] * alpha;
    }
    bf16x8 pf[2];
#pragma unroll
    for (int s2 = 0; s2 < 2; ++s2) { u32x4 w; w.x = pk2(s[2 * s2][0], s[2 * s2][1]); w.y = pk2(s[2 * s2][2], s[2 * s2][3]); w.z = pk2(s[2 * s2 + 1][0], s[2 * s2 + 1][1]); w.w = pk2(s[2 * s2 + 1][2], s[2 * s2 + 1][3]);
        pf[s2] = __builtin_bit_cast(bf16x8, w); }
    AT_SB;
    if (VB == 4) {
        AT_RDV(vb, 4); AT_MMV(va, 0); AT_SB;
        AT_MMV(vb, 4); AT_SB;
    } else {
        AT_RDV(vb, 2); AT_MMV(va, 0); AT_SB;
        AT_RDV(va, 4); AT_MMV(vb, 2); AT_SB;
        AT_RDV(vb, 6); AT_MMV(va, 4); AT_SB;
        AT_MMV(vb, 6); AT_SB;
    }
#undef AT_SB
#undef AT_RDK
#undef AT_MMK
#undef AT_RDV
#undef AT_MMV
}

template <int NSLAB>
__device__ __forceinline__ void attn_pass(LAS unsigned char* lds, const Pass P, int b, int q0, int kt_lo, int kt_hi, const bf16x8 (&qf)[NSLAB], unsigned bits, int t,
                                          f32x4 (&o)[8], float& l_out, int tid, int wave, int lane) {
    constexpr int KS = NSLAB * 64 + 16;
    constexpr int VOFF = 64 * KS, BUF = VOFF + 64 * VS;
    const int r16 = lane & 15, g4 = lane >> 4, q4 = r16 >> 2, p4 = r16 & 3;
    const int tmin = q0 + wave * 16, tmax = tmin + 15;
    float m = NEGB, l = 0.f;
    { float z0 = 0.f; asm volatile("" : "+v"(z0));
#pragma unroll
      for (int dt = 0; dt < 8; ++dt) o[dt] = (f32x4){z0, z0, z0, z0}; }
    u32x4 rk1[4], rv[4], rk2[2];
#pragma unroll
    for (int i = 0; i < 2; ++i) rk2[i] = (u32x4){0u, 0u, 0u, 0u};
#define ATT_LOAD2(kt) do { \
        _Pragma("unroll") for (int i = 0; i < 4; ++i) { const int c = tid + i * 512, row = c >> 4, ch = c & 15; int key = (kt) * 64 + row; key = key > SEQ - 1 ? SEQ - 1 : key; const size_t rowg = (size_t)b * SEQ + key; \
            rk1[i] = *(const u32x4*)(P.K1 + rowg * P.ldk1 + ch * 8); rv[i] = *(const u32x4*)(P.V + rowg * P.ldv + ch * 8); } \
        if (NSLAB == 6) { _Pragma("unroll") for (int i = 0; i < 2; ++i) { const int c = tid + i * 512, row = c >> 3, ch = c & 7; int key = (kt) * 64 + row; key = key > SEQ - 1 ? SEQ - 1 : key; \
            rk2[i] = *(const u32x4*)(P.K2 + ((size_t)b * SEQ + key) * P.ldk2 + ch * 8); } } } while (0)
#define ATT_STORE2() do { \
        _Pragma("unroll") for (int i = 0; i < 4; ++i) { const int c = tid + i * 512, row = c >> 4, ch = c & 15; LAS unsigned char* B_ = lds + (row >> 6) * BUF; \
            *(LAS u32x4*)(B_ + (row & 63) * KS + ch * 16) = rk1[i]; *(LAS u32x4*)(B_ + VOFF + (row & 63) * VS + ch * 16) = rv[i]; } \
        if (NSLAB == 6) { _Pragma("unroll") for (int i = 0; i < 2; ++i) { const int c = tid + i * 512, row = c >> 3, ch = c & 7; \
            *(LAS u32x4*)(lds + (row >> 6) * BUF + (row & 63) * KS + 256 + ch * 16) = rk2[i]; } } } while (0)
#define ATT_BAR do { asm volatile("s_waitcnt lgkmcnt(0)" ::: "memory"); __builtin_amdgcn_s_barrier(); asm volatile("" ::: "memory"); } while (0)
#define ATT_ACTIVE(kb) ((kb) <= tmax && (kb) + 63 > tmin - P.window)
#define ATT_NOMASK(kb) ((kb) + 63 <= tmin && (kb) > tmax - P.window)
    const int nt = kt_hi - kt_lo + 1, ns = (nt + 1) >> 1;
    ATT_LOAD2(kt_lo);
    for (int is = 0; is < ns; ++is) {
        const int kt = kt_lo + 2 * is;
        ATT_BAR;
        ATT_STORE2();
        ATT_BAR;
        if (is + 1 < ns) ATT_LOAD2(kt + 2);
        { const int kb = kt * 64; if (ATT_ACTIVE(kb)) attn_tile<NSLAB>(lds, kb, ATT_NOMASK(kb), P.window, P.shift, P.sc, qf, bits, t, o, m, l, r16, g4, q4, p4); }
        if (kt + 1 <= kt_hi) { const int kb = (kt + 1) * 64; if (ATT_ACTIVE(kb)) attn_tile<NSLAB>(lds + BUF, kb, ATT_NOMASK(kb), P.window, P.shift, P.sc, qf, bits, t, o, m, l, r16, g4, q4, p4); }
    }
#undef ATT_LOAD2
#undef ATT_STORE2
#undef ATT_BAR
#undef ATT_ACTIVE
#undef ATT_NOMASK
    l_out = l;
}
__device__ __forceinline__ float row_total(float l) { return xsum4(l); }

__device__ __forceinline__ void moba_unit(LAS unsigned char* lds, unsigned char* ws, int u) {
    int tid = threadIdx.x; asm volatile("" : "+v"(tid));
    const int lane = tid & 63, wave = __builtin_amdgcn_readfirstlane(tid >> 6), r16 = lane & 15, g4 = lane >> 4;
    const int qt = 15 - u / 16, bh = u % 16, b = bh >> 2, h = bh & 3, q0 = qt * 128;
    const bf16_t* Z = (const bf16_t*)(ws + WS_Z);
    const int t = q0 + wave * 16 + r16;
    float qv[4][8];
    load_q<4>(Z + (size_t)(b * SEQ + t) * ZW + Z_AQ + h * 128, t, g4, (const float*)(ws + WS_COSH), (const float*)(ws + WS_SINH), qv);
    const int own = q0 >> 8;
    unsigned bits;
    {
        const float* KM = (const float*)(ws + WS_KM) + (size_t)(b * 8) * 512 + h * 128;
        float gate[7];
#pragma unroll
        for (int n = 0; n < 7; ++n) { float a = 0.f;
            if (n < own) {
#pragma unroll
                for (int s = 0; s < 4; ++s) { const float* kp = KM + n * 512 + s * 32 + g4 * 8; const f32x4 k0 = *(const f32x4*)kp, k1 = *(const f32x4*)(kp + 4);
                    a += qv[s][0] * k0[0] + qv[s][1] * k0[1] + qv[s][2] * k0[2] + qv[s][3] * k0[3] + qv[s][4] * k1[0] + qv[s][5] * k1[1] + qv[s][6] * k1[2] + qv[s][7] * k1[3]; }
                a = xsum4(a);
            }
            gate[n] = a; }
        unsigned sel = 0u;
        if (own <= 3) sel = (1u << own) - 1u;
        else {
#pragma unroll
            for (int k = 0; k < 3; ++k) { float best = -3.0e38f; int bi = 0;
#pragma unroll
                for (int n = 0; n < 7; ++n) if (n < own && !((sel >> n) & 1u) && gate[n] > best) { best = gate[n]; bi = n; }
                sel |= 1u << bi; }
        }
        bits = sel | (1u << own);
    }
    bf16x8 qf[4];
#pragma unroll
    for (int s = 0; s < 4; ++s) qf[s] = pack8(qv[s]);
    Pass P; P.K1 = Z + Z_AK + h * 128; P.K2 = nullptr; P.V = Z + Z_AV + h * 128; P.ldk1 = ZW; P.ldk2 = 0; P.ldv = ZW; P.window = 1 << 30; P.shift = 8; P.sc = 0.08838834764831845f * 1.4426950408889634f;
    f32x4 o[8]; float l;
    attn_pass<4>(lds, P, b, q0, 0, (q0 + 127) >> 6, qf, bits, t, o, l, tid, wave, lane);
    const float inv = 1.f / fmaxf(row_total(l), 1e-30f);
    bf16_t* yrow = (bf16_t*)(ws + WS_YA) + (size_t)(b * SEQ + t) * 2048 + h * 128 + g4 * 4;
#pragma unroll
    for (int dt = 0; dt < 8; ++dt) { u32x2 w; w.x = pk2(o[dt][0] * inv, o[dt][1] * inv); w.y = pk2(o[dt][2] * inv, o[dt][3] * inv); *(u32x2*)(yrow + dt * 16) = w; }
}

__device__ __forceinline__ void mla_unit(LAS unsigned char* lds, unsigned char* ws, int u) {
    int tid = threadIdx.x; asm volatile("" : "+v"(tid));
    const int lane = tid & 63, wave = __builtin_amdgcn_readfirstlane(tid >> 6), r16 = lane & 15, g4 = lane >> 4;
    const int qt = 15 - u / 24, bh = u % 24, b = bh / 6, h = bh % 6, q0 = qt * 128;
    const int t = q0 + wave * 16 + r16;
    float qv[6][8];
    load_q<6>((const bf16_t*)(ws + WS_QF) + (size_t)(b * SEQ + t) * 1152 + h * 192, t, g4, (const float*)(ws + WS_COSR), (const float*)(ws + WS_SINR), qv);
    bf16x8 qf[6];
#pragma unroll
    for (int s = 0; s < 6; ++s) qf[s] = pack8(qv[s]);
    const bf16_t* KVF = (const bf16_t*)(ws + WS_KVF);
    Pass P; P.K1 = KVF + h * 256; P.K2 = (const bf16_t*)(ws + WS_Z) + Z_KR; P.V = KVF + h * 256 + 128; P.ldk1 = 1536; P.ldk2 = ZW; P.ldv = 1536; P.window = 1 << 30; P.shift = 6;
    P.sc = 0.07216878364870322f * 1.4426950408889634f;
    f32x4 o[8]; float l;
    attn_pass<6>(lds, P, b, q0, 0, (q0 + 127) >> 6, qf, 0xffffffffu, t, o, l, tid, wave, lane);
    const float inv = 1.f / fmaxf(row_total(l), 1e-30f);
    bf16_t* yrow = (bf16_t*)(ws + WS_YA) + (size_t)(b * SEQ + t) * 2048 + 512 + h * 128 + g4 * 4;
#pragma unroll
    for (int dt = 0; dt < 8; ++dt) { u32x2 w; w.x = pk2(o[dt][0] * inv, o[dt][1] * inv); w.y = pk2(o[dt][2] * inv, o[dt][3] * inv); *(u32x2*)(yrow + dt * 16) = w; }
}

__device__ __forceinline__ void nsa_unit(LAS unsigned char* lds, unsigned char* ws, int u) {
    int tid = threadIdx.x; asm volatile("" : "+v"(tid));
    const int lane = tid & 63, wave = __builtin_amdgcn_readfirstlane(tid >> 6), r16 = lane & 15, g4 = lane >> 4;
    const int qt = 15 - u / 24, bh = u % 24, b = bh / 6, hd = bh % 6, g = hd / 3, q0 = qt * 128;
    const bf16_t* Z = (const bf16_t*)(ws + WS_Z);
    const int t = q0 + wave * 16 + r16;
    const size_t trow = (size_t)(b * SEQ + t);
    float qv[4][8];
    load_q<4>(Z + trow * ZW + Z_NQ + hd * 128, t, g4, (const float*)(ws + WS_COSH), (const float*)(ws + WS_SINH), qv);
    bf16x8 qf[4];
#pragma unroll
    for (int s = 0; s < 4; ++s) qf[s] = pack8(qv[s]);
    const float g1 = pg8::sigm_f(bf2f(Z[trow * ZW + Z_GATE + hd * 3 + 1])), g2 = pg8::sigm_f(bf2f(Z[trow * ZW + Z_GATE + hd * 3 + 2]));
    const unsigned selb = ((const unsigned*)(ws + WS_SELB))[(size_t)(b * 2 + g) * SEQ + t];
    f32x4 acc[8];
    {
        Pass P; P.K1 = Z + Z_KS + g * 128; P.K2 = nullptr; P.V = Z + Z_VS + g * 128; P.ldk1 = ZW; P.ldk2 = 0; P.ldv = ZW; P.window = 1 << 30; P.shift = 6; P.sc = 0.08838834764831845f * 1.4426950408889634f;
        f32x4 o[8]; float l;
        attn_pass<4>(lds, P, b, q0, 0, (q0 + 127) >> 6, qf, selb, t, o, l, tid, wave, lane);
        const float w = g1 / fmaxf(row_total(l), 1e-30f);
#pragma unroll
        for (int dt = 0; dt < 8; ++dt) acc[dt] = o[dt] * w;
    }
    {
        Pass P; P.K1 = Z + Z_KW + g * 128; P.K2 = nullptr; P.V = Z + Z_VW + g * 128; P.ldk1 = ZW; P.ldk2 = 0; P.ldv = ZW; P.window = 512; P.shift = 6; P.sc = 0.08838834764831845f * 1.4426950408889634f;
        f32x4 o[8]; float l;
        const int klo = q0 - 511 > 0 ? (q0 - 511) >> 6 : 0;
        attn_pass<4>(lds, P, b, q0, klo, (q0 + 127) >> 6, qf, 0xffffffffu, t, o, l, tid, wave, lane);
        const float w = g2 / fmaxf(row_total(l), 1e-30f);
#pragma unroll
        for (int dt = 0; dt < 8; ++dt) acc[dt] = acc[dt] + o[dt] * w;
    }
    const float* oc = (const float*)(ws + WS_OC) + trow * 768 + hd * 128 + g4 * 4;
    bf16_t* yrow = (bf16_t*)(ws + WS_YA) + trow * 2048 + 1280 + hd * 128 + g4 * 4;
#pragma unroll
    for (int dt = 0; dt < 8; ++dt) { const f32x4 c = *(const f32x4*)(oc + dt * 16); const f32x4 v = acc[dt] + c;
        u32x2 w; w.x = pk2(v[0], v[1]); w.y = pk2(v[2], v[3]); *(u32x2*)(yrow + dt * 16) = w; }
}

__device__ __forceinline__ void nsa_cmp_unit(LAS unsigned char* lds, unsigned char* ws, int u, bool stage) {
    int tid = threadIdx.x; asm volatile("" : "+v"(tid));
    const int lane = tid & 63, wave = __builtin_amdgcn_readfirstlane(tid >> 6), r16 = lane & 15, g4 = lane >> 4, q4 = r16 >> 2, p4 = r16 & 3;
    const int bg = u >> 6, b = bg >> 1, g = bg & 1, q0 = (u & 63) * 32;
    constexpr int KOFF = 0, VOFFC = 128 * VS, PBOFF = 2 * 128 * VS, PBS = 132, IMPOFF = PBOFF + 3 * 32 * PBS * 4;
    const float* cosT = (const float*)(ws + WS_COSH); const float* sinT = (const float*)(ws + WS_SINH);
    __syncthreads();
    if (stage) {
        const float* KC = (const float*)(ws + WS_KCMP) + (size_t)bg * 128 * 128; const float* VC = (const float*)(ws + WS_VCMP) + (size_t)bg * 128 * 128;
#pragma unroll
        for (int i = 0; i < 2; ++i) { const int c = tid + i * 512, n = c >> 3, ch = c & 7;
            int pos = 16 * n + 31; pos = pos > SEQ - 1 ? SEQ - 1 : pos;
            const float* kp = KC + n * 128 + ch * 8; float lo[8], hi[8], cs[8], sn[8];
            *(f32x4*)lo = *(const f32x4*)kp; *(f32x4*)(lo + 4) = *(const f32x4*)(kp + 4); *(f32x4*)hi = *(const f32x4*)(kp + 64); *(f32x4*)(hi + 4) = *(const f32x4*)(kp + 68);
            *(f32x4*)cs = *(const f32x4*)(cosT + pos * 64 + ch * 8); *(f32x4*)(cs + 4) = *(const f32x4*)(cosT + pos * 64 + ch * 8 + 4);
            *(f32x4*)sn = *(const f32x4*)(sinT + pos * 64 + ch * 8); *(f32x4*)(sn + 4) = *(const f32x4*)(sinT + pos * 64 + ch * 8 + 4);
            float a[8], bb[8];
#pragma unroll
            for (int j = 0; j < 8; ++j) { a[j] = lo[j] * cs[j] - hi[j] * sn[j]; bb[j] = hi[j] * cs[j] + lo[j] * sn[j]; }
            *(LAS bf16x8*)(lds + KOFF + n * VS + ch * 16) = pack8(a); *(LAS bf16x8*)(lds + KOFF + n * VS + 128 + ch * 16) = pack8(bb); }
#pragma unroll
        for (int i = 0; i < 4; ++i) { const int c = tid + i * 512, n = c >> 4, ch = c & 15; const float* vp = VC + n * 128 + ch * 8; float v[8];
            *(f32x4*)v = *(const f32x4*)vp; *(f32x4*)(v + 4) = *(const f32x4*)(vp + 4);
            *(LAS bf16x8*)(lds + VOFFC + n * VS + ch * 16) = pack8(v); }
    }
    __syncthreads();
    const bf16_t* Z = (const bf16_t*)(ws + WS_Z);
    if (wave < 6) {
        const int r = wave >> 1, qs = wave & 1, hd = g * 3 + r, t = q0 + qs * 16 + r16; const size_t trow = (size_t)(b * SEQ + t);
        float qv[4][8];
        load_q<4>(Z + trow * ZW + Z_NQ + hd * 128, t, g4, cosT, sinT, qv);
        bf16x8 qf[4];
#pragma unroll
        for (int s = 0; s < 4; ++s) qf[s] = pack8(qv[s]);
        f32x4 s[8];
#pragma unroll
        for (int sub = 0; sub < 8; ++sub) { s[sub] = (f32x4){0.f, 0.f, 0.f, 0.f};
#pragma unroll
            for (int sl = 0; sl < 4; ++sl) { const bf16x8 kf = *(const LAS bf16x8*)(lds + KOFF + (sub * 16 + r16) * VS + sl * 64 + g4 * 16);
                s[sub] = __builtin_amdgcn_mfma_f32_16x16x32_bf16(kf, qf[sl], s[sub], 0, 0, 0); } }
        const float sc = 0.08838834764831845f * 1.4426950408889634f;
        float mx = NEGB;
#pragma unroll
        for (int sub = 0; sub < 8; ++sub)
#pragma unroll
            for (int j = 0; j < 4; ++j) { const int n = sub * 16 + g4 * 4 + j; const bool ok = (16 * n + 31 <= t); const float v = ok ? s[sub][j] * sc : NEGB; s[sub][j] = v; mx = fmaxf(mx, v); }
        mx = xmax4(mx);
        float ls = 0.f;
#pragma unroll
        for (int sub = 0; sub < 8; ++sub)
#pragma unroll
            for (int j = 0; j < 4; ++j) { const float p = s[sub][j] > -1e29f ? __builtin_amdgcn_exp2f(s[sub][j] - mx) : 0.f; s[sub][j] = p; ls += p; }
        ls = row_total(ls);
        const float inv = 1.f / fmaxf(ls, 1e-30f);
        LAS float* pb = (LAS float*)(lds + PBOFF) + (size_t)(r * 32 + qs * 16 + r16) * PBS + g4 * 4;
#pragma unroll
        for (int sub = 0; sub < 8; ++sub) { s[sub] = s[sub] * inv; *(LAS f32x4*)(pb + sub * 16) = s[sub]; }
        f32x4 o[8];
        { float z0 = 0.f; asm volatile("" : "+v"(z0));
#pragma unroll
          for (int dt = 0; dt < 8; ++dt) o[dt] = (f32x4){z0, z0, z0, z0}; }
#pragma unroll
        for (int s2 = 0; s2 < 4; ++s2) { u32x4 w; w.x = pk2(s[2 * s2][0], s[2 * s2][1]); w.y = pk2(s[2 * s2][2], s[2 * s2][3]); w.z = pk2(s[2 * s2 + 1][0], s[2 * s2 + 1][1]); w.w = pk2(s[2 * s2 + 1][2], s[2 * s2 + 1][3]);
            const bf16x8 pf = __builtin_bit_cast(bf16x8, w);
#pragma unroll
            for (int dt = 0; dt < 8; ++dt) { LAS unsigned char* vp = lds + VOFFC + (s2 * 32 + g4 * 4 + q4) * VS + (dt * 16 + 4 * p4) * 2;
                const bf16x8 vf = vtr2(vp, vp + 16 * VS);
                o[dt] = __builtin_amdgcn_mfma_f32_16x16x32_bf16(vf, pf, o[dt], 0, 0, 0); } }
        const float g0 = pg8::sigm_f(bf2f(Z[trow * ZW + Z_GATE + hd * 3 + 0]));
        float* oc = (float*)(ws + WS_OC) + trow * 768 + hd * 128 + g4 * 4;
#pragma unroll
        for (int dt = 0; dt < 8; ++dt) *(f32x4*)(oc + dt * 16) = o[dt] * g0;
    }
    __syncthreads();
    {
        const LAS float* PB = (const LAS float*)(lds + PBOFF); LAS float* IMP = (LAS float*)(lds + IMPOFF);
#pragma unroll
        for (int k = 0; k < 2; ++k) { const int idx = tid + 512 * k, q = idx >> 5, j = idx & 31, t = q0 + q, cur = t >> 6;
            const int n0 = 4 * j - 1 < 0 ? 0 : 4 * j - 1, n1 = 4 * j + 3 > 126 ? 126 : 4 * j + 3;
            float a = 0.f;
            for (int r = 0; r < 3; ++r) for (int n = n0; n <= n1; ++n) a += PB[(r * 32 + q) * PBS + n];
            if (j == 0 || j == cur || j == cur - 1) a = 1e9f;
            if (j > cur) a = -__builtin_inff();
            IMP[q * 32 + j] = a; }
    }
    __syncthreads();
    {
        const LAS float* IMP = (const LAS float*)(lds + IMPOFF);
#pragma unroll
        for (int k = 0; k < 2; ++k) { const int idx = tid + 512 * k, q = idx >> 5, j = idx & 31; const float me = IMP[q * 32 + j];
            int rank = 0;
            for (int jj = 0; jj < 32; ++jj) { const float o = IMP[q * 32 + jj]; rank += (o > me || (o == me && jj < j)) ? 1 : 0; }
            const unsigned long long bal = __ballot(rank < 16);
            if ((lane & 31) == 0) ((unsigned*)(ws + WS_SELB))[(size_t)bg * SEQ + q0 + q] = (unsigned)(bal >> (lane & 32)); }
    }
}
}

__device__ __forceinline__ void prep_unit(LAS unsigned char* lds, unsigned char* ws, const float* qn, const float* kvn, int u) {
    using att::unpack8;
    int tid = threadIdx.x; asm volatile("" : "+v"(tid));
    const int lane = tid & 63, wave = __builtin_amdgcn_readfirstlane(tid >> 6);
    bf16_t* Z = (bf16_t*)(ws + WS_Z);
    const float* cosH = (const float*)(ws + WS_COSH); const float* sinH = (const float*)(ws + WS_SINH);
    const float* cosR = (const float*)(ws + WS_COSR); const float* sinR = (const float*)(ws + WS_SINR);
    float ksum[8];
#pragma unroll
    for (int i = 0; i < 8; ++i) ksum[i] = 0.f;
    for (int k = 0; k < 4; ++k) {
        const int tok = u * 32 + wave * 4 + k, sq = tok & (SEQ - 1), b = tok >> 11;
        bf16_t* zr = Z + (size_t)tok * ZW;
        float cs[8], sn[8];
        { const float* cp = cosH + sq * 64 + (lane & 7) * 8; const float* sp = sinH + sq * 64 + (lane & 7) * 8;
          *(f32x4*)cs = *(const f32x4*)cp; *(f32x4*)(cs + 4) = *(const f32x4*)(cp + 4); *(f32x4*)sn = *(const f32x4*)sp; *(f32x4*)(sn + 4) = *(const f32x4*)(sp + 4); }
        const bool hi = (lane & 8) != 0;
        {
            float v[8], o[8]; unpack8(*(const u32x4*)(zr + Z_AK + lane * 8), v);
#pragma unroll
            for (int i = 0; i < 8; ++i) { const float pr = __shfl_xor(v[i], 8); o[i] = hi ? v[i] * cs[i] + pr * sn[i] : v[i] * cs[i] - pr * sn[i]; ksum[i] += o[i]; }
            *(bf16x8*)(zr + Z_AK + lane * 8) = att::pack8(o);
        }
        {
            bf16_t* p = zr + (lane < 32 ? Z_KS : Z_KW) + (lane & 31) * 8;
            float v[8], o[8]; unpack8(*(const u32x4*)p, v);
#pragma unroll
            for (int i = 0; i < 8; ++i) { const float pr = __shfl_xor(v[i], 8); o[i] = hi ? v[i] * cs[i] + pr * sn[i] : v[i] * cs[i] - pr * sn[i]; }
            *(bf16x8*)p = att::pack8(o);
        }
        {
            const int l8 = lane & 7; bf16_t* p = zr + Z_KR + l8 * 8;
            float v[8], o[8], c2[8], s2[8]; unpack8(*(const u32x4*)p, v);
            { const float* cp = cosR + sq * 32 + (l8 & 3) * 8; const float* sp = sinR + sq * 32 + (l8 & 3) * 8;
              *(f32x4*)c2 = *(const f32x4*)cp; *(f32x4*)(c2 + 4) = *(const f32x4*)(cp + 4); *(f32x4*)s2 = *(const f32x4*)sp; *(f32x4*)(s2 + 4) = *(const f32x4*)(sp + 4); }
            const bool h2 = (l8 & 4) != 0;
#pragma unroll
            for (int i = 0; i < 8; ++i) { const float pr = __shfl_xor(v[i], 4); o[i] = h2 ? v[i] * c2[i] + pr * s2[i] : v[i] * c2[i] - pr * s2[i]; }
            if (lane < 8) *(bf16x8*)p = att::pack8(o);
        }
        {
            float v[8], o[8]; unpack8(*(const u32x4*)(zr + Z_CQ + lane * 8), v);
            float ss = 0.f;
#pragma unroll
            for (int i = 0; i < 8; ++i) ss += v[i] * v[i];
            const float rstd = 1.f / sqrtf(wave_sum(ss) * (1.f / 512.f) + 1e-6f);
            const f32x4 g0 = *(const f32x4*)(qn + lane * 8), g1 = *(const f32x4*)(qn + lane * 8 + 4);
#pragma unroll
            for (int i = 0; i < 8; ++i) o[i] = v[i] * rstd * (i < 4 ? g0[i & 3] : g1[i & 3]);
            *(bf16x8*)((bf16_t*)(ws + WS_CQN) + (size_t)tok * 512 + lane * 8) = att::pack8(o);
            const int l5 = lane & 31;
            unpack8(*(const u32x4*)(zr + Z_CKV + l5 * 8), v);
            ss = 0.f;
#pragma unroll
            for (int i = 0; i < 8; ++i) ss += v[i] * v[i];
            const float rstd2 = 1.f / sqrtf(wave_sum(ss) * 0.5f * (1.f / 256.f) + 1e-6f);
            const f32x4 h0 = *(const f32x4*)(kvn + l5 * 8), h1 = *(const f32x4*)(kvn + l5 * 8 + 4);
#pragma unroll
            for (int i = 0; i < 8; ++i) o[i] = v[i] * rstd2 * (i < 4 ? h0[i & 3] : h1[i & 3]);
            if (lane < 32) *(bf16x8*)((bf16_t*)(ws + WS_CKVN) + (size_t)tok * 256 + l5 * 8) = att::pack8(o);
        }
        {
            const u32x4 w = *(const u32x4*)(zr + Z_KC + lane * 8);
            const int which = lane >> 5, g = (lane >> 4) & 1, d = (lane & 15) * 8;
            bf16_t* dst = (bf16_t*)(ws + (which ? WS_VCP : WS_KCP)) + ((size_t)(b * 2 + g) * SEQ + sq) * 128 + d;
            *(u32x4*)dst = w;
        }
    }
    LAS float* red = (LAS float*)lds;
    __syncthreads();
#pragma unroll
    for (int i = 0; i < 8; ++i) red[wave * 512 + lane * 8 + i] = ksum[i];
    __syncthreads();
    { float a = 0.f;
#pragma unroll
      for (int w = 0; w < 8; ++w) a += red[w * 512 + tid];
      ((float*)(ws + WS_KMP))[(size_t)u * 512 + tid] = a; }
}

struct AttOrder { unsigned short u[640]; };
constexpr AttOrder make_att_order() {
    AttOrder t{}; int n = 0;
    for (int c = 50; c >= 4; --c) {
        if ((c - 5) % 3 == 0 && (c - 5) / 3 <= 15 && c >= 5) { const int qt = (c - 5) / 3; for (int i = 0; i < 24; ++i) t.u[n++] = (unsigned short)((15 - qt) * 24 + i); }
        if ((c - 4) % 2 == 0 && (c - 4) / 2 <= 15) { const int qt = (c - 4) / 2; for (int i = 0; i < 16; ++i) t.u[n++] = (unsigned short)(0x1000 | ((15 - qt) * 16 + i)); }
    }
    return t;
}
__constant__ AttOrder ATT_ORDER = make_att_order();

__device__ __forceinline__ void gbar(unsigned* ctr, unsigned& target, unsigned G) {
    asm volatile("s_waitcnt vmcnt(0) lgkmcnt(0)" ::: "memory");
    __syncthreads();
    target += G;
    if (threadIdx.x < 64) {
        if (threadIdx.x == 0) {
            __builtin_amdgcn_fence(__ATOMIC_RELEASE, "agent");
            asm volatile("s_waitcnt vmcnt(0)" ::: "memory");
            __hip_atomic_fetch_add(ctr, 1u, __ATOMIC_RELAXED, __HIP_MEMORY_SCOPE_AGENT);
            while (__hip_atomic_load(ctr, __ATOMIC_RELAXED, __HIP_MEMORY_SCOPE_AGENT) < target) __builtin_amdgcn_s_sleep(2);
        }
        __builtin_amdgcn_fence(__ATOMIC_ACQUIRE, "agent");
        asm volatile("s_waitcnt vmcnt(0)" ::: "memory");
    }
    __syncthreads();
}

#define XB_TMO      128
#define XB_XCNT(j)  (256  + 64 * (j))
#define XB_XSUB(j)  (1280 + 64 * (j))
#define XB_XGEN(j)  (2304 + 64 * (j))
#define XB_TOP      3328
#define XB_TOPGEN   3392
#define XCD_BAR_WORDS 3456
#define XB_SPIN_CAP (1u << 18)
__device__ __forceinline__ unsigned xb_ld(unsigned* p)              { return __hip_atomic_load(p, __ATOMIC_RELAXED, __HIP_MEMORY_SCOPE_AGENT); }
__device__ __forceinline__ unsigned xb_add(unsigned* p, unsigned v) { return __hip_atomic_fetch_add(p, v, __ATOMIC_RELAXED, __HIP_MEMORY_SCOPE_AGENT); }
__device__ __forceinline__ unsigned xb_xcc_id() { return (unsigned)__builtin_amdgcn_s_getreg((3 << 11) | 20) & 0xFu; }
#define XB_SPIN(cond, bar) do { unsigned _sp = 0; while (cond) { __builtin_amdgcn_s_sleep(1); \
    if ((++_sp & 255u) == 0u) { if (xb_ld(&(bar)[XB_TMO])) break; if (_sp > XB_SPIN_CAP) { atomicAdd(&(bar)[XB_TMO], 1u); break; } } } } while (0)
__device__ __forceinline__ void xcd_barrier_complete(unsigned* bar, unsigned x, unsigned& nloc, unsigned& nx) {
    const unsigned G = gridDim.x * gridDim.y * gridDim.z;
    unsigned sum, cnt, mine, sp = 0u;
    for (;;) {
        sum = 0u; cnt = 0u; mine = 0u;
#pragma unroll
        for (unsigned j = 0; j < 16; ++j) { const unsigned c = xb_ld(&bar[XB_XCNT(j)]); sum += c; cnt += (c > 0u) ? 1u : 0u; mine = (j == x) ? c : mine; }
        if (sum == G) break;
        __builtin_amdgcn_s_sleep(1);
        if ((++sp & 255u) == 0u) { if (xb_ld(&bar[XB_TMO])) break; if (sp > XB_SPIN_CAP) { atomicAdd(&bar[XB_TMO], 1u); break; } }
    }
    nloc = mine > 0u ? mine : 1u; nx = cnt > 0u ? cnt : 1u;
}
__device__ __forceinline__ void xcd_barrier(unsigned* bar, volatile LAS unsigned* st) {
    asm volatile("s_waitcnt vmcnt(0) lgkmcnt(0)" ::: "memory");
    __syncthreads();
    if (threadIdx.x == 0) {
        const unsigned x = xb_xcc_id();
        __builtin_amdgcn_s_waitcnt(0);
        unsigned nloc = st[0], nx = st[1];
        if (nloc == 0u) { xcd_barrier_complete(bar, x, nloc, nx); st[0] = nloc; st[1] = nx; }
        const unsigned old = xb_add(&bar[XB_XSUB(x)], 1u);
        const unsigned gen = old / nloc;
        if (old + 1u == (gen + 1u) * nloc) {
            __builtin_amdgcn_fence(__ATOMIC_RELEASE, "agent");
            asm volatile("s_waitcnt vmcnt(0)" ::: "memory");
            const unsigned og = xb_add(&bar[XB_TOP], 1u);
            const unsigned tg = og / nx;
            if (og + 1u == (tg + 1u) * nx) xb_add(&bar[XB_TOPGEN], 1u);
            else XB_SPIN(xb_ld(&bar[XB_TOPGEN]) == tg, bar);
            __builtin_amdgcn_fence(__ATOMIC_ACQUIRE, "agent");
            xb_add(&bar[XB_XGEN(x)], 1u);
            asm volatile("s_waitcnt vmcnt(0)" ::: "memory");
        } else {
            XB_SPIN(xb_ld(&bar[XB_XGEN(x)]) == gen, bar);
            __builtin_amdgcn_fence(__ATOMIC_ACQUIRE, "agent");
            asm volatile("s_waitcnt vmcnt(0)" ::: "memory");
        }
    }
    __syncthreads();
}

struct Args { const float* in[26]; float* out; unsigned char* ws; };

__device__ __forceinline__ int opq(int v) { asm volatile("" : "+s"(v)); return v; }
__global__ void __launch_bounds__(NTHREADS, 2) mega_fwd(Args args) {
    extern __shared__ __attribute__((aligned(16))) unsigned char lds_raw[];
    LAS unsigned char* lds = (LAS unsigned char*)lds_raw;
    cg::grid_group grid = cg::this_grid();
    const int G = gridDim.x, bx = blockIdx.x, NGW = G * NWAVES;
    unsigned bar_target = 0u; (void)bar_target;
    if (bx == 0) { for (int i = threadIdx.x; i < 3456; i += NTHREADS) __hip_atomic_store((unsigned*)(args.ws + WS_XB) + i, 0u, __ATOMIC_RELAXED, __HIP_MEMORY_SCOPE_AGENT); }
    if (threadIdx.x < 2) ((volatile LAS unsigned*)(lds + 147200))[threadIdx.x] = 0u;
    __syncthreads();
    if (bx == 0 && threadIdx.x == 0) __hip_atomic_store((unsigned*)(args.ws + WS_BAR), 0u, __ATOMIC_RELAXED, __HIP_MEMORY_SCOPE_AGENT);
    if (bx == 0 && threadIdx.x >= 32 && threadIdx.x < 40) __hip_atomic_store((unsigned*)(args.ws + WS_BAR) + threadIdx.x, 0u, __ATOMIC_RELAXED, __HIP_MEMORY_SCOPE_AGENT);
#define PHASE_IDS int tid = threadIdx.x; asm volatile("" : "+v"(tid)); int bxl = bx; asm volatile("" : "+s"(bxl)); const int lane = tid & 63, wave = __builtin_amdgcn_readfirstlane(tid >> 6), gw = bxl * NWAVES + wave; (void)lane; (void)gw;
#define GBAR xcd_barrier((unsigned*)(args.ws + WS_XB), (volatile LAS unsigned*)(lds + 147200))
#define LWS unsigned char* ws = args.ws; asm volatile("" : "+s"(ws));
#define X ((bf16_t*)(ws + WS_X))
#define H ((bf16_t*)(ws + WS_H))
#define ACT ((bf16_t*)(ws + WS_Z))
#define AIN(i) (args.in[opq(i)])
#define CONV_DECODE(itv, lyr) do { int m_ = 0; while (CONV_TAB[m_].end <= (itv)) ++m_; const ConvTab e_ = CONV_TAB[m_]; const int r_ = (itv) - (m_ ? CONV_TAB[m_ - 1].end : 0), nblk_ = (e_.N + 255) >> 8; \
                dsc.W = args.in[e_.idx] + (size_t)(lyr) * e_.K * e_.N; dsc.WT = (bf16_t*)(ws + (size_t)e_.off256 * 256); dsc.K = e_.K; dsc.N = e_.N; dsc.kind = e_.kind; dsc.ldw = e_.ldw; dsc.koff = e_.koff; \
                { const int gi_ = (e_.idx == 6) ? 5 : (e_.idx == 22 || e_.idx == 23) ? 21 : ((e_.idx == 2 || e_.idx == 3) && (lyr) > 0) ? 1 : -1; const float* gp_ = args.in[gi_ < 0 ? 0 : gi_] + (size_t)(lyr) * D; dsc.gain = gi_ < 0 ? nullptr : gp_; } \
                dsc.k0 = 64 * (r_ / nblk_); dsc.n0 = 256 * (r_ % nblk_); } while (0)
#define CONV_RUN(first, last, rank, nranks, lyr) do { \
                LAS float* tile = (LAS float*)lds; \
                ConvDesc dsc{}; f32x4 cv[8]; \
                _Pragma("unroll") for (int r = 0; r < 8; ++r) cv[r] = (f32x4){0.f, 0.f, 0.f, 0.f}; \
                int it = (first) + (rank); \
                if (it < (last)) { CONV_DECODE(it, lyr); conv_load(dsc, wave, lane, cv); } \
                while (it < (last)) { \
                    conv_lds_write(tile, wave, lane, cv); \
                    __syncthreads(); \
                    const ConvDesc cur = dsc; \
                    const int nx = it + (nranks); \
                    if (nx < (last)) { CONV_DECODE(nx, lyr); conv_load(dsc, wave, lane, cv); } \
                    conv_store(cur, tile, tid); \
                    __syncthreads(); \
                    it = nx; \
                } } while (0)

    for (int layer = 0; layer < DEPTH; ++layer) {

        {
            PHASE_IDS LWS
            {
                const int e0 = layer == 0 ? CE2 : CE1;
                CONV_RUN(0, e0, bxl, G, layer);
                CONV_RUN(CE3, CE4, (bxl + G - e0 % G) % G, G, layer);
                CONV_RUN(CE5, CE16, (bxl + G - (e0 + CE4 - CE3) % G) % G, G, layer);
            }
            for (int it = gw; it < 512; it += NGW) { const int kv = it >> 8, kc = (it >> 2) & 63, c = (it & 3) * 64 + lane;
                const float* pos = AIN(kv ? 14 : 11) + (size_t)layer * 4096 + kc * 64; const float* w1 = AIN(kv ? 15 : 12) + (size_t)layer * 4096 * 256 + (size_t)kc * 64 * 256 + c;
                float a = 0.f;
#pragma unroll 8
                for (int k = 0; k < 64; ++k) a += pos[k] * w1[(size_t)k * 256];
                ((float*)(ws + WS_BPART))[(kv * 64 + kc) * 256 + c] = a; }
            if (layer == 0) {
                for (int i = bx * NTHREADS + tid; i < SEQ * 96; i += G * NTHREADS) {
                    const int pos = i / 96, f = i % 96; const bool hd = f < 64; const int fi = hd ? f : f - 64;
                    const float ex = hd ? (float)fi / 64.f : (float)fi / 32.f;
                    const float inv = 1.0f / powf(10000.0f, ex);
                    const float ang = (float)pos * inv;
                    double rv = (double)ang * 0.15915494309189535; rv -= rint(rv);
                    const float fr = (float)rv;
                    const float c = __builtin_amdgcn_cosf(fr), sn = __builtin_amdgcn_sinf(fr);
                    if (hd) { ((float*)(ws + WS_COSH))[pos * 64 + fi] = c; ((float*)(ws + WS_SINH))[pos * 64 + fi] = sn; }
                    else { ((float*)(ws + WS_COSR))[pos * 32 + fi] = c; ((float*)(ws + WS_SINR))[pos * 32 + fi] = sn; }
                }
            }
            const float* ffn1_norm_p = AIN(1) + (size_t)layer * D; const float* x_in = AIN(0);
            if (layer == 0) { for (int m = gw; m < T; m += NGW) rms_row_bf16(x_in + (size_t)m * D, ffn1_norm_p, H + (size_t)m * D, lane); }
        }
        if (layer == 0) { grid.sync(); if (threadIdx.x == 0) (void)xb_add((unsigned*)(args.ws + WS_XB) + XB_XCNT(xb_xcc_id()), 1u); } else GBAR;
        { LWS pg8::Gemm g{layer == 0 ? (const bf16_t*)H : (const bf16_t*)X, (const bf16_t*)(ws + WS_GU1), D, D, T, 2 * DFF, D}; pg8::StaticOrder S; S.init(T, 2 * DFF, G, opq(bx));
          pg8::EpiSwiglu E{ACT, DFF, layer == 0 ? (const float*)nullptr : (const float*)(ws + WS_SSP)}; pg8::gemm_phase(lds, g, S, E); }
        { constexpr int full = ((T / 256) * (2 * DFF / 256)) % 256;
          if (G == 256 && bx >= full) { PHASE_IDS LWS CONV_RUN(CE4, CE5, bxl - full, G - full, layer); }
          else if (G != 256) { PHASE_IDS LWS CONV_RUN(CE4, CE5, bxl, G, layer); } }
        GBAR;
        { LWS pg8::Gemm g{ACT, (const bf16_t*)(ws + WS_DN1), DFF, DFF, T, D, DFF}; pg8::StaticOrder S; S.init(T, D, G, opq(bx));
          if (layer == 0) { pg8::EpiResidual<true, 1, (long)WS_SSP - (long)WS_X> E{X, AIN(0)}; pg8::gemm_phase(lds, g, S, E); }
          else { pg8::EpiResidual<false, 1, (long)WS_SSP - (long)WS_X> E{X, nullptr}; pg8::gemm_phase(lds, g, S, E); } }
        GBAR;
        { LWS pg8::Gemm g{X, (const bf16_t*)(ws + WS_WIN), D, D, T, ZW, D}; pg8::StaticOrder S; S.init(T, ZW, G, opq(bx));
          pg8::EpiBf16<0> E{(bf16_t*)(ws + WS_Z), ZW, ZW, nullptr, (const float*)(ws + WS_SSP)}; pg8::gemm_phase(lds, g, S, E); }
        { constexpr int full = ((T / 256) * (ZW / 256)) % 256;
          if (G == 256 && bx >= full) { PHASE_IDS LWS CONV_RUN(CE2, CE3, bxl - full, G - full, layer); }
          else if (G != 256) { PHASE_IDS LWS CONV_RUN(CE2, CE3, bxl, G, layer); } }
        GBAR;
        {
            LWS
            for (int u = bx; u < T / 32; u += G) prep_unit(lds, ws, AIN(7) + (size_t)layer * 512, AIN(9) + (size_t)layer * 256, u);
            if (bx == G - 1) { PHASE_IDS const float* bp = (const float*)(ws + WS_BPART) + (tid >> 8) * 64 * 256 + (tid & 255); float a = 0.f;
                for (int k = 0; k < 64; ++k) a += bp[k * 256];
                ((float*)(ws + WS_BIAS))[tid] = a; }
        }
        GBAR;
        {
            { PHASE_IDS LWS for (int i = bx * NTHREADS + tid; i < 32 * 512; i += G * NTHREADS) { const float* p = (const float*)(ws + WS_KMP) + (size_t)(i >> 9) * 8 * 512 + (i & 511); float a = 0.f;
#pragma unroll
                for (int k = 0; k < 8; ++k) a += p[k * 512];
                ((float*)(ws + WS_KM))[i] = a * (1.f / 256.f); } }
            { LWS pg8::Gemm g{(const bf16_t*)(ws + WS_CQN), (const bf16_t*)(ws + WS_UQ), 512, 512, T, 1280, 512}; pg8::StaticOrder S; S.init(T, 1280, G, opq(bx));
              pg8::EpiBf16<0> E{(bf16_t*)(ws + WS_QF), 1152, 1152, nullptr}; pg8::gemm_phase(lds, g, S, E); }
            { LWS pg8::Gemm g{(const bf16_t*)(ws + WS_CKVN), (const bf16_t*)(ws + WS_UKV), 256, 256, T, 1536, 256}; pg8::StaticOrder S; S.init(T, 1536, G == 256 ? 96 : G, opq(G == 256 ? (bx >= 160 ? bx - 160 : (1 << 20)) : (bx + G - 160 % G) % G));
              pg8::EpiBf16<0> E{(bf16_t*)(ws + WS_KVF), 1536, 1536, nullptr}; pg8::gemm_phase(lds, g, S, E); }
        }
        GBAR;
        {
            int Gl = G; asm volatile("" : "+s"(Gl));
            const int NCMP = 16;
            if (bx < NCMP) {
                PHASE_IDS LWS
                const int kv = bxl >> 3, half = (bxl >> 2) & 1, rtile = bxl & 3;
                unsigned* flag = (unsigned*)(ws + WS_BAR) + 32 + kv * 4 + rtile;
                float* part = (float*)(ws + WS_H1P) + (size_t)kv * 1024 * 256;
                pg8::Gemm g{(const bf16_t*)(ws + (kv ? WS_VCP : WS_KCP)) + half * 2048, (const bf16_t*)(ws + (kv ? WS_W1V : WS_W1K)) + half * 2048, 2048, 4096, 1024, 256, 2048};
                pg8::StaticOrder S; S.init(1024, 256, 4, opq(rtile));
                if (half == 0) {
                    pg8::EpiF32 E{part, 256, 256}; pg8::gemm_phase(lds, g, S, E);
                    asm volatile("s_waitcnt vmcnt(0)" ::: "memory");
                    __syncthreads();
                    if (tid == 0) { __builtin_amdgcn_fence(__ATOMIC_RELEASE, "agent"); asm volatile("s_waitcnt vmcnt(0)" ::: "memory");
                        __hip_atomic_fetch_add(flag, 1u, __ATOMIC_RELAXED, __HIP_MEMORY_SCOPE_AGENT); }
                } else {
                    pg8::EpiCmpFinish E{(bf16_t*)(ws + (kv ? WS_H1V : WS_H1K)), part, (const float*)(ws + WS_BIAS) + kv * 256, flag, (unsigned)(layer + 1)};
                    pg8::gemm_phase(lds, g, S, E);
                    asm volatile("s_waitcnt vmcnt(0)" ::: "memory");
                    __syncthreads();
                    const int rt0 = rtile * 16, r16 = lane & 15, g4 = lane >> 4;
                    for (int wt = wave; wt < 128; wt += NWAVES) { const int rt = rt0 + (wt >> 3), ct = wt & 7;
                        const bf16_t* Ap = (const bf16_t*)(ws + (kv ? WS_H1V : WS_H1K)) + (size_t)(rt * 16 + r16) * 256 + g4 * 8;
                        const bf16_t* Bp = (const bf16_t*)(ws + (kv ? WS_W2V : WS_W2K)) + (size_t)(ct * 16 + r16) * 256 + g4 * 8;
                        f32x4 c = {0.f, 0.f, 0.f, 0.f};
#pragma unroll
                        for (int ks = 0; ks < 8; ++ks) { const bf16x8 a = *(const bf16x8*)(Ap + ks * 32), bq = *(const bf16x8*)(Bp + ks * 32); c = __builtin_amdgcn_mfma_f32_16x16x32_bf16(a, bq, c, 0, 0, 0); }
                        float* op = (float*)(ws + (kv ? WS_VCMP : WS_KCMP)) + (size_t)(rt * 16 + g4 * 4) * 128 + ct * 16 + r16;
#pragma unroll
                        for (int j = 0; j < 4; ++j) op[j * 128] = c[j]; }
                }
            }
            if (bx >= NCMP) {
                LWS
                const int vb = bx - NCMP, VG = G - NCMP;
                for (int r = 0; r * VG < 640; ++r) { const int p = r * VG + ((r & 1) ? VG - 1 - vb : vb);
                    if (p < 640) { const int code = ATT_ORDER.u[p];
                        if (code & 0x1000) att::moba_unit(lds, ws, code & 0xfff); else att::mla_unit(lds, ws, code); } }
            }
        }
        GBAR;
        { LWS
          if (G == 256) { att::nsa_cmp_unit(lds, ws, 2 * bx, true); att::nsa_cmp_unit(lds, ws, 2 * bx + 1, false); }
          else { for (int u = bx; u < 512; u += G) att::nsa_cmp_unit(lds, ws, u, true); } }
        GBAR;
        { LWS for (int r = 0; r * G < 384; ++r) { const int p = r * G + ((r & 1) ? G - 1 - bx : bx); if (p < 384) att::nsa_unit(lds, ws, p); } }
        GBAR;
        { LWS pg8::Gemm g{(const bf16_t*)(ws + WS_YA), (const bf16_t*)(ws + WS_BRA), D, D, T, D, D}; pg8::StaticOrder S; S.init(T, D, G, opq(bx));
          pg8::EpiMergeH E{H, (const bf16_t*)(ws + WS_Z) + Z_MERGE, ZW}; pg8::gemm_phase(lds, g, S, E); }
        GBAR;
        { LWS pg8::Gemm g{H, (const bf16_t*)(ws + WS_WO), D, D, T, D, D}; pg8::StaticOrder S; S.init(T, D, G, opq(bx));
          pg8::EpiResidual<false, 2, (long)WS_SSP - (long)WS_X> E{X, nullptr}; pg8::gemm_phase(lds, g, S, E); }
        GBAR;
        { LWS pg8::Gemm g{X, (const bf16_t*)(ws + WS_GU2), D, D, T, 2 * DFF, D}; pg8::StaticOrder S; S.init(T, 2 * DFF, G, opq(bx));
          pg8::EpiSwiglu E{ACT, DFF, (const float*)(ws + WS_SSP)}; pg8::gemm_phase(lds, g, S, E); }
        if (layer + 1 < DEPTH) { constexpr int full = ((T / 256) * (2 * DFF / 256)) % 256;
          if (G == 256 && bx >= full) { PHASE_IDS LWS CONV_RUN(CE1, CE2, bxl - full, G - full, layer + 1); }
          else if (G != 256) { PHASE_IDS LWS CONV_RUN(CE1, CE2, bxl, G, layer + 1); } }
        GBAR;
        { LWS pg8::Gemm g{ACT, (const bf16_t*)(ws + WS_DN2), DFF, DFF, T, D, DFF}; pg8::StaticOrder S; S.init(T, D, G, opq(bx));
          pg8::EpiResidual<false, 1, (long)WS_SSP - (long)WS_X> E{X, nullptr}; pg8::gemm_phase(lds, g, S, E); }
        GBAR;
    }
    { PHASE_IDS LWS const float* gp = AIN(25); float* outp = args.out; for (int m = gw; m < T; m += NGW) rms_xrow_f32(X + (size_t)m * D, gp, outp + (size_t)m * D, lane); }
}

extern "C" void kernel_launch(void* const* d_in, const int* in_sizes, int n_in, void* d_out, int out_size, void* d_ws, size_t ws_size, hipStream_t stream) {
    static int grid_blocks = 0;
    if (grid_blocks == 0) {
        if (n_in != 26 || ws_size < WS_END0) { fprintf(stderr, "kernel_launch: unexpected n_in %d / ws_size %zu (need %zu)\n", n_in, ws_size, (size_t)WS_END0); grid_blocks = -1; return; }
        int dev = 0, cus = 0, per_cu = 0;
        hipGetDevice(&dev);
        hipDeviceGetAttribute(&cus, hipDeviceAttributeMultiprocessorCount, dev);
        if (hipFuncSetAttribute((const void*)mega_fwd, hipFuncAttributeMaxDynamicSharedMemorySize, LDS_BYTES) != hipSuccess) fprintf(stderr, "kernel_launch: hipFuncSetAttribute failed\n");
        if (hipOccupancyMaxActiveBlocksPerMultiprocessor(&per_cu, (const void*)mega_fwd, NTHREADS, LDS_BYTES) != hipSuccess || per_cu < 1) { fprintf(stderr, "kernel_launch: occupancy query gave %d\n", per_cu); per_cu = 1; }
        (void)hipGetLastError();
        grid_blocks = cus * per_cu;
    }
    if (grid_blocks < 0) return;
    Args a{};
    for (int i = 0; i < 26; ++i) a.in[i] = (const float*)d_in[i];
    a.out = (float*)d_out; a.ws = (unsigned char*)d_ws;
    void* kargs[] = {&a};
    hipError_t e = hipLaunchCooperativeKernel((const void*)mega_fwd, dim3(grid_blocks), dim3(NTHREADS), kargs, LDS_BYTES, stream);
    if (e != hipSuccess) fprintf(stderr, "cooperative launch failed: %s (grid %d)\n", hipGetErrorString(e), grid_blocks);
}
```

```cpp
#include <hip/hip_runtime.h>
#include <hip/hip_cooperative_groups.h>
#include <cstdint>
#include <cstdio>
namespace cg = cooperative_groups;

#define LAS __attribute__((address_space(3)))
typedef unsigned short bf16_t;
typedef short bf16x8 __attribute__((ext_vector_type(8)));
typedef float f32x4 __attribute__((ext_vector_type(4)));
typedef float f32x2 __attribute__((ext_vector_type(2)));
typedef unsigned u32x4 __attribute__((ext_vector_type(4)));
typedef unsigned u32x2 __attribute__((ext_vector_type(2)));

constexpr int T = 8192, D = 2048, DFF = 5632, SEQ = 2048, NBATCH = 4, DEPTH = 2;
constexpr int IN_COLS = 10834, ZW = 11008;
constexpr int Z_AQ = 0, Z_AK = 512, Z_AV = 1024, Z_CQ = 1536, Z_CKV = 2048, Z_KR = 2304, Z_NQ = 2368, Z_KC = 3136, Z_VC = 3392,
              Z_KS = 3648, Z_VS = 3904, Z_KW = 4160, Z_VW = 4416, Z_GATE = 4672, Z_MERGE = 4736;
constexpr int NWAVES = 8, NTHREADS = 512;
constexpr int LDS_BYTES = 147456;

__device__ __forceinline__ unsigned f2bf(float f) { unsigned u = __builtin_bit_cast(unsigned, f); return (u + 0x7fffu + ((u >> 16) & 1u)) >> 16; }
typedef __bf16 bf16x2_t __attribute__((ext_vector_type(2)));
__device__ __forceinline__ unsigned pk2(float lo, float hi) { const f32x2 v = {lo, hi}; const bf16x2_t h = __builtin_convertvector(v, bf16x2_t); return __builtin_bit_cast(unsigned, h); }
__device__ __forceinline__ float xmax4(float v) { v = fmaxf(v, __shfl_xor(v, 16)); return fmaxf(v, __shfl_xor(v, 32)); }
__device__ __forceinline__ float xsum4(float v) { v += __shfl_xor(v, 16); return v + __shfl_xor(v, 32); }
__device__ __forceinline__ float bf2f(unsigned short b) { return __builtin_bit_cast(float, (unsigned)b << 16); }
__device__ __forceinline__ float wave_sum(float v) {
#pragma unroll
    for (int o = 1; o < 64; o <<= 1) v += __shfl_xor(v, o);
    return v;
}

namespace pg8 {
constexpr int BM = 256, BK = 64, HALF = 128, HTB = HALF * BK * 2, STAGE_BYTES = 8 * HTB, NXCD = 8, WGM = 8;
__host__ __device__ __forceinline__ int lds_byte(int r, int c) { const int st = (r >> 4) * 2 + (c >> 5), rr = r & 15, cc = c & 31, ob = rr * 64 + cc * 2; return st * 1024 + (ob ^ (((ob >> 9) & 1) << 5)); }
__host__ __device__ __forceinline__ void stage_rc(int b, int& R, int& C) { const int st = b / 1024, sb = b % 1024, swz = sb ^ (((sb >> 9) & 1) << 5); R = (st >> 1) * 16 + swz / 64; C = (st & 1) * 32 + (swz % 64) / 2; }
__host__ __device__ __forceinline__ int perm32(int rho) { const int n = rho >> 4, i = rho & 15; return 8 * (i >> 2) + 4 * n + (i & 3); }

struct Unit { int pm, pn; };
struct Gemm { const bf16_t* A; const bf16_t* Bt; int lda, ldb, M, N, K; };

struct StaticOrder {
    int nM, nN, nwg, G, c;
    __device__ void init(int M, int N, int G_, int c_) { nM = M / BM; nN = N / BM; nwg = nM * nN; G = G_; c = c_; }
    __device__ bool next(int i, Unit& u) const {
        const long L = (long)i * G + c; if (L >= nwg) return false;
        int wgid = (int)L; { const int q = nwg / NXCD, r = nwg % NXCD, xcd = wgid % NXCD, off = wgid / NXCD; wgid = (xcd < r ? xcd * (q + 1) : r * (q + 1) + (xcd - r) * q) + off; }
        const int nig = WGM * nN, gid = wgid / nig, fm = gid * WGM, gsz = (nM - fm) < WGM ? (nM - fm) : WGM;
        u.pm = fm + ((wgid % nig) % gsz); u.pn = (wgid % nig) / gsz; return true;
    }
};

template <class Epi>
__device__ __forceinline__ void gemm_phase(LAS unsigned char* lds, const Gemm g, const StaticOrder& S, const Epi E) {
    int tid = threadIdx.x; asm volatile("" : "+v"(tid));
    const int wid = __builtin_amdgcn_readfirstlane(tid >> 6), lane = tid & 63, wr = wid >> 2, wc = wid & 3, fr = lane & 15, fq = lane >> 4;
    const int K = g.K, nt = K / BK;
    unsigned voffA[2], voffB[2];
#pragma unroll
    for (int i = 0; i < 2; ++i) { int R, C; stage_rc(tid * 16 + i * 8192, R, C); const int Rb = (R & ~31) + perm32(R & 31);
        voffA[i] = (unsigned)(R * g.lda + C) * 2u; voffB[i] = (unsigned)(Rb * g.ldb + C) * 2u; }
    const size_t kstep = (size_t)(BK * 2);
    const size_t hstepA = (size_t)HALF * g.lda * 2, hstepB = (size_t)HALF * g.ldb * 2;
    const size_t tstepA = 2 * hstepA, tstepB = 2 * hstepB;
    const unsigned ldsw = (unsigned)wid * 1024u;
    const int aoff = lds_byte(wr * 64 + fr, fq * 8), boff = lds_byte(wc * 32 + fr, fq * 8);
#define PG8_SA(b, h) (((b) * 2 + (h)) * HTB)
#define PG8_SB(b, h) ((4 + (b) * 2 + (h)) * HTB)
#define PG8_STAGE(bufoff, gbase, voff) do { _Pragma("unroll") for (int _i = 0; _i < 2; ++_i) \
        __builtin_amdgcn_global_load_lds((const unsigned*)((const char*)(gbase) + (voff)[_i]), (LAS unsigned*)(lds + (bufoff) + ldsw + _i * 8192), 16, 0, 0); } while (0)
#define PG8_LDA(dst, b, h) do { _Pragma("unroll") for (int m = 0; m < 4; ++m) _Pragma("unroll") for (int k = 0; k < 2; ++k) dst[m][k] = *(const LAS bf16x8*)(lds + PG8_SA(b, h) + aoff + m * 2048 + k * 1024); } while (0)
#define PG8_LDB(dst, b, h) do { _Pragma("unroll") for (int n = 0; n < 2; ++n) _Pragma("unroll") for (int k = 0; k < 2; ++k) dst[n][k] = *(const LAS bf16x8*)(lds + PG8_SB(b, h) + boff + n * 2048 + k * 1024); } while (0)
#define PG8_MMA(ai, bj, At, Bt) do { __builtin_amdgcn_s_setprio(1); _Pragma("unroll") for (int m = 0; m < 4; ++m) _Pragma("unroll") for (int n = 0; n < 2; ++n) _Pragma("unroll") for (int k = 0; k < 2; ++k) \
        acc[ai][bj][m][n] = __builtin_amdgcn_mfma_f32_16x16x32_bf16(Bt[n][k], At[m][k], acc[ai][bj][m][n], 0, 0, 0); __builtin_amdgcn_s_setprio(0); } while (0)
#define PG8_WAIT_V(n) asm volatile("s_waitcnt vmcnt(" #n ")" ::: "memory")
#define PG8_WAIT_L(n) asm volatile("s_waitcnt lgkmcnt(" #n ")" ::: "memory")
#define PG8_BAR __builtin_amdgcn_s_barrier()
#define PG8_SCHED __builtin_amdgcn_sched_barrier(0)
    Unit cur, nxt; int ui = 0;
    if (!S.next(0, cur)) return;
    f32x4 acc[2][2][4][2];
#pragma unroll
    for (int a = 0; a < 2; ++a)
#pragma unroll
        for (int b = 0; b < 2; ++b)
#pragma unroll
            for (int m = 0; m < 4; ++m)
#pragma unroll
                for (int n = 0; n < 2; ++n) acc[a][b][m][n] = (f32x4){0.f, 0.f, 0.f, 0.f};
    bf16x8 At[4][2], B0[2][2], B1[2][2];
    const char* cA = (const char*)g.A + (size_t)cur.pm * tstepA; const char* cB = (const char*)g.Bt + (size_t)cur.pn * tstepB;
    PG8_STAGE(PG8_SB(0, 0), cB, voffB); PG8_STAGE(PG8_SB(0, 1), cB + hstepB, voffB); PG8_STAGE(PG8_SA(0, 0), cA, voffA); PG8_STAGE(PG8_SA(0, 1), cA + hstepA, voffA);
    if (wr == 1) PG8_BAR;
    PG8_WAIT_V(2); PG8_BAR;
    PG8_STAGE(PG8_SB(1, 0), cB + kstep, voffB); PG8_STAGE(PG8_SA(1, 0), cA + kstep, voffA); PG8_STAGE(PG8_SB(1, 1), cB + hstepB + kstep, voffB);
    PG8_WAIT_V(6); PG8_BAR;
    for (;;) {
        const bool has_next = S.next(ui + 1, nxt);
        const char* nA = has_next ? (const char*)g.A + (size_t)nxt.pm * tstepA : cA; const char* nB = has_next ? (const char*)g.Bt + (size_t)nxt.pn * tstepB : cB;
        for (int t = 0; t < nt; t += 2) {
            const bool last = (t == nt - 2);
            const char* a1 = cA + (size_t)(t + 1) * kstep;
            const char* a2 = last ? nA : cA + (size_t)(t + 2) * kstep; const char* b2 = last ? nB : cB + (size_t)(t + 2) * kstep;
            const char* a3 = a2 + kstep; const char* b3 = b2 + kstep;
            if constexpr (Epi::HOOK) { if (t == Epi::HK1 || t == Epi::HK2) { int fr2 = fr, fq2 = fq; asm volatile("" : "+v"(fr2), "+v"(fq2)); E.hook(acc, cur, wr, wc, fr2, fq2, t == Epi::HK1 ? 0 : 1); PG8_SCHED; } }
            PG8_LDB(B0, 0, 0); PG8_LDB(B1, 0, 1); PG8_SCHED; PG8_LDA(At, 0, 0); PG8_STAGE(PG8_SA(1, 1), a1 + hstepA, voffA);
            PG8_WAIT_V(8); PG8_WAIT_L(0); PG8_BAR; PG8_MMA(0, 0, At, B0); PG8_MMA(0, 1, At, B1); PG8_BAR; PG8_SCHED;
            PG8_LDA(At, 0, 1); PG8_STAGE(PG8_SB(0, 0), b2, voffB); PG8_STAGE(PG8_SB(0, 1), b2 + hstepB, voffB); PG8_STAGE(PG8_SA(0, 0), a2, voffA);
            PG8_WAIT_V(8); PG8_WAIT_L(0); PG8_BAR; PG8_MMA(1, 0, At, B0); PG8_MMA(1, 1, At, B1); PG8_BAR; PG8_SCHED;
            PG8_LDB(B0, 1, 0); PG8_LDB(B1, 1, 1); PG8_SCHED; PG8_LDA(At, 1, 0); PG8_STAGE(PG8_SA(0, 1), a2 + hstepA, voffA);
            PG8_WAIT_V(8); PG8_WAIT_L(0); PG8_BAR; PG8_MMA(0, 0, At, B0); PG8_MMA(0, 1, At, B1); PG8_BAR; PG8_SCHED;
            PG8_LDA(At, 1, 1); PG8_STAGE(PG8_SB(1, 0), b3, voffB); PG8_STAGE(PG8_SB(1, 1), b3 + hstepB, voffB); PG8_STAGE(PG8_SA(1, 0), a3, voffA);
            PG8_WAIT_V(8); PG8_WAIT_L(0); PG8_BAR; PG8_MMA(1, 0, At, B0); PG8_MMA(1, 1, At, B1); PG8_BAR; PG8_SCHED;
        }
        if (wr == 0) PG8_BAR;
        { int fr2 = fr, fq2 = fq; asm volatile("" : "+v"(fr2), "+v"(fq2)); E(acc, cur, wr, wc, fr2, fq2, lds); }
        if (!has_next) break;
#pragma unroll
        for (int a = 0; a < 2; ++a)
#pragma unroll
            for (int b = 0; b < 2; ++b)
#pragma unroll
                for (int m = 0; m < 4; ++m)
#pragma unroll
                    for (int n = 0; n < 2; ++n) acc[a][b][m][n] = (f32x4){0.f, 0.f, 0.f, 0.f};
        cur = nxt; cA = nA; cB = nB; ++ui;
        if (wr == 1) PG8_BAR;
    }
    PG8_WAIT_V(0);
    PG8_BAR;
#undef PG8_SA
#undef PG8_SB
#undef PG8_STAGE
#undef PG8_LDA
#undef PG8_LDB
#undef PG8_MMA
#undef PG8_WAIT_V
#undef PG8_WAIT_L
#undef PG8_BAR
#undef PG8_SCHED
}

typedef f32x4 Acc[2][2][4][2];
__device__ __forceinline__ float silu_f(float x) { return x * __builtin_amdgcn_rcpf(1.f + __builtin_amdgcn_exp2f(-1.4426950408889634f * x)); }
__device__ __forceinline__ float sigm_f(float x) { return __builtin_amdgcn_rcpf(1.f + __builtin_amdgcn_exp2f(-1.4426950408889634f * x)); }
__device__ __forceinline__ float gelu_tanh_f(float x) { const float u = 0.7978845608028654f * (x + 0.044715f * x * x * x); return x * __builtin_amdgcn_rcpf(1.f + __builtin_amdgcn_exp2f(-2.8853900817779268f * u)); }

__device__ __forceinline__ float row_rstd(const float* ssp, size_t row) {
    const f32x4 p0 = *(const f32x4*)(ssp + row * 8), p1 = *(const f32x4*)(ssp + row * 8 + 4);
    return __builtin_amdgcn_rsqf((((p0[0] + p0[1]) + (p0[2] + p0[3])) + ((p1[0] + p1[1]) + (p1[2] + p1[3]))) * (1.f / D) + 1e-6f);
}
struct EpiSwiglu {
    static constexpr bool HOOK = false;
    bf16_t* O; int ldo; const float* ssp = nullptr;
    __device__ __forceinline__ void operator()(const Acc& acc, const Unit& u, int wr, int wc, int fr, int fq, LAS unsigned char* ldsb) const {
        const int row0 = u.pm * BM + wr * 64 + fr, col0 = u.pn * HALF + wc * 32 + fq * 8;
#pragma unroll
        for (int ai = 0; ai < 2; ++ai)
#pragma unroll
            for (int m = 0; m < 4; ++m) {
                const float rs = ssp ? row_rstd(ssp, (size_t)(row0 + ai * HALF + m * 16)) : 1.f;
                const f32x4 g0 = acc[ai][0][m][0] * rs, g1 = acc[ai][0][m][1] * rs, u0 = acc[ai][1][m][0] * rs, u1 = acc[ai][1][m][1] * rs;
                u32x4 w;
                w.x = pk2(silu_f(g0[0]) * u0[0], silu_f(g0[1]) * u0[1]); w.y = pk2(silu_f(g0[2]) * u0[2], silu_f(g0[3]) * u0[3]);
                w.z = pk2(silu_f(g1[0]) * u1[0], silu_f(g1[1]) * u1[1]); w.w = pk2(silu_f(g1[2]) * u1[2], silu_f(g1[3]) * u1[3]);
                *(u32x4*)(O + (size_t)(row0 + ai * HALF + m * 16) * ldo + col0) = w;
            }
    }
};
template <bool F32IN, int SC2  , long SSP_OFF  > struct EpiResidual {
    static constexpr bool HOOK = false;
    bf16_t* X; const float* Xin32;
    __device__ __forceinline__ void operator()(const Acc& acc, const Unit& u, int wr, int wc, int fr, int fq, LAS unsigned char* ldsb) const {
        const int row0 = u.pm * BM + wr * 64 + fr, col0 = u.pn * BM + wc * 32 + fq * 8;
        constexpr int ldx = D; constexpr float scale = 0.5f * SC2;
        float* ssp = (float*)((char*)X + SSP_OFF);
        float ss[2][4];
#pragma unroll
        for (int ai = 0; ai < 2; ++ai)
#pragma unroll
            for (int m = 0; m < 4; ++m) ss[ai][m] = 0.f;
#pragma unroll
        for (int ai = 0; ai < 2; ++ai)
#pragma unroll
            for (int m = 0; m < 4; ++m)
#pragma unroll
                for (int bj = 0; bj < 2; ++bj) {
                    const size_t off = (size_t)(row0 + ai * HALF + m * 16) * ldx + col0 + bj * HALF;
                    f32x4 a, b;
                    if (F32IN) { a = *(const f32x4*)(Xin32 + off); b = *(const f32x4*)(Xin32 + off + 4); }
                    else { const u32x4 w = *(const u32x4*)(X + off);
                        a = (f32x4){__builtin_bit_cast(float, w.x << 16), __builtin_bit_cast(float, w.x & 0xffff0000u), __builtin_bit_cast(float, w.y << 16), __builtin_bit_cast(float, w.y & 0xffff0000u)};
                        b = (f32x4){__builtin_bit_cast(float, w.z << 16), __builtin_bit_cast(float, w.z & 0xffff0000u), __builtin_bit_cast(float, w.w << 16), __builtin_bit_cast(float, w.w & 0xffff0000u)}; }
                    a = a + acc[ai][bj][m][0] * scale; b = b + acc[ai][bj][m][1] * scale;
                    u32x4 o; o.x = pk2(a[0], a[1]); o.y = pk2(a[2], a[3]); o.z = pk2(b[0], b[1]); o.w = pk2(b[2], b[3]);
                    *(u32x4*)(X + off) = o;
                    { const float r0 = __builtin_bit_cast(float, o.x << 16), r1 = __builtin_bit_cast(float, o.x & 0xffff0000u), r2 = __builtin_bit_cast(float, o.y << 16), r3 = __builtin_bit_cast(float, o.y & 0xffff0000u),
                                  r4 = __builtin_bit_cast(float, o.z << 16), r5 = __builtin_bit_cast(float, o.z & 0xffff0000u), r6 = __builtin_bit_cast(float, o.w << 16), r7 = __builtin_bit_cast(float, o.w & 0xffff0000u);
                      ss[ai][m] += ((r0 * r0 + r1 * r1) + (r2 * r2 + r3 * r3)) + ((r4 * r4 + r5 * r5) + (r6 * r6 + r7 * r7)); }
                    if (bj == 1 && m == 3) __builtin_amdgcn_sched_barrier(0);
                }
        LAS float* red = (LAS float*)(ldsb + 131072);
        {
#pragma unroll
            for (int ai = 0; ai < 2; ++ai)
#pragma unroll
                for (int m = 0; m < 4; ++m) { float t = ss[ai][m]; t += __shfl_xor(t, 16); t += __shfl_xor(t, 32);
                    if (fq == 0) red[(ai * HALF + wr * 64 + m * 16 + fr) * 4 + wc] = t; }
            asm volatile("s_waitcnt lgkmcnt(0)" ::: "memory"); __builtin_amdgcn_s_barrier(); asm volatile("" ::: "memory");
            const int tl = (wr * 4 + wc) * 64 + fq * 16 + fr;
            if (tl < 256) { const f32x4 q = *(const LAS f32x4*)(red + tl * 4); ssp[(size_t)(u.pm * BM + tl) * 8 + u.pn] = (q[0] + q[1]) + (q[2] + q[3]); }
        }
    }
};
template <int ACT> struct EpiBf16 {
    static constexpr bool HOOK = false;
    bf16_t* O; int ldo, ncols; const float* bias; const float* ssp = nullptr;
    __device__ __forceinline__ void operator()(const Acc& acc, const Unit& u, int wr, int wc, int fr, int fq, LAS unsigned char* ldsb) const {
        const int row0 = u.pm * BM + wr * 64 + fr, col0 = u.pn * BM + wc * 32 + fq * 8;
#pragma unroll
        for (int bj = 0; bj < 2; ++bj) {
            const int col = col0 + bj * HALF; if (col >= ncols) continue;
            f32x4 b0 = {0.f, 0.f, 0.f, 0.f}, b1 = {0.f, 0.f, 0.f, 0.f};
            if (ACT == 1) { b0 = *(const f32x4*)(bias + col); b1 = *(const f32x4*)(bias + col + 4); }
#pragma unroll
            for (int ai = 0; ai < 2; ++ai)
#pragma unroll
                for (int m = 0; m < 4; ++m) {
                    const float rs = ssp ? row_rstd(ssp, (size_t)(row0 + ai * HALF + m * 16)) : 1.f;
                    f32x4 v0 = acc[ai][bj][m][0] * rs + b0, v1 = acc[ai][bj][m][1] * rs + b1;
                    if (ACT == 1) {
#pragma unroll
                        for (int j = 0; j < 4; ++j) { v0[j] = gelu_tanh_f(v0[j]); v1[j] = gelu_tanh_f(v1[j]); }
                    }
                    u32x4 w; w.x = pk2(v0[0], v0[1]); w.y = pk2(v0[2], v0[3]); w.z = pk2(v1[0], v1[1]); w.w = pk2(v1[2], v1[3]);
                    *(u32x4*)(O + (size_t)(row0 + ai * HALF + m * 16) * ldo + col) = w;
                }
        }
    }
};
struct EpiF32 {
    static constexpr bool HOOK = false;
    float* O; int ldo, ncols;
    __device__ __forceinline__ void operator()(const Acc& acc, const Unit& u, int wr, int wc, int fr, int fq, LAS unsigned char* ldsb) const {
        const int row0 = u.pm * BM + wr * 64 + fr, col0 = u.pn * BM + wc * 32 + fq * 8;
#pragma unroll
        for (int bj = 0; bj < 2; ++bj) {
            const int col = col0 + bj * HALF; if (col >= ncols) continue;
#pragma unroll
            for (int ai = 0; ai < 2; ++ai)
#pragma unroll
                for (int m = 0; m < 4; ++m) {
                    float* p = O + (size_t)(row0 + ai * HALF + m * 16) * ldo + col;
                    *(f32x4*)p = acc[ai][bj][m][0]; *(f32x4*)(p + 4) = acc[ai][bj][m][1];
                }
        }
    }
};
template <int MODE> struct EpiMerge {
    static constexpr bool HOOK = false;
    float* buf; bf16_t* Obf; const bf16_t* gate; int ldg;
    __device__ __forceinline__ void operator()(const Acc& acc, const Unit& u, int wr, int wc, int fr, int fq, LAS unsigned char* ldsb) const {
        const int row0 = u.pm * BM + wr * 64 + fr, col0 = u.pn * BM + wc * 32 + fq * 8;
#pragma unroll
        for (int ai = 0; ai < 2; ++ai)
#pragma unroll
            for (int m = 0; m < 4; ++m)
#pragma unroll
                for (int bj = 0; bj < 2; ++bj) {
                    const size_t row = (size_t)(row0 + ai * HALF + m * 16); const int col = col0 + bj * HALF;
                    const u32x4 gw = *(const u32x4*)(gate + row * ldg + col);
                    f32x4 v0 = acc[ai][bj][m][0], v1 = acc[ai][bj][m][1];
                    v0[0] *= sigm_f(__builtin_bit_cast(float, gw.x << 16)); v0[1] *= sigm_f(__builtin_bit_cast(float, gw.x & 0xffff0000u));
                    v0[2] *= sigm_f(__builtin_bit_cast(float, gw.y << 16)); v0[3] *= sigm_f(__builtin_bit_cast(float, gw.y & 0xffff0000u));
                    v1[0] *= sigm_f(__builtin_bit_cast(float, gw.z << 16)); v1[1] *= sigm_f(__builtin_bit_cast(float, gw.z & 0xffff0000u));
                    v1[2] *= sigm_f(__builtin_bit_cast(float, gw.w << 16)); v1[3] *= sigm_f(__builtin_bit_cast(float, gw.w & 0xffff0000u));
                    float* p = buf + row * D + col;
                    if (MODE >= 1) { v0 = v0 + *(f32x4*)p; v1 = v1 + *(f32x4*)(p + 4); }
                    if (MODE <= 1) { *(f32x4*)p = v0; *(f32x4*)(p + 4) = v1; }
                    else { u32x4 w; w.x = pk2(v0[0], v0[1]); w.y = pk2(v0[2], v0[3]); w.z = pk2(v1[0], v1[1]); w.w = pk2(v1[2], v1[3]); *(u32x4*)(Obf + row * D + col) = w; }
                    if (bj == 1) __builtin_amdgcn_sched_barrier(0);
                }
    }
};
struct EpiMergeH {
    static constexpr bool HOOK = true; static constexpr int HK1 = 8, HK2 = 20;
    bf16_t* Obf; const bf16_t* gate; int ldg;
    __device__ __forceinline__ void hook(Acc& acc, const Unit& u, int wr, int wc, int fr, int fq, int which) const {
        const int row0 = u.pm * BM + wr * 64 + fr, col0 = u.pn * BM + wc * 32 + fq * 8;
        const bf16_t* gp = gate + (size_t)which * D;
#pragma unroll
        for (int ai = 0; ai < 2; ++ai)
#pragma unroll
            for (int m = 0; m < 4; ++m)
#pragma unroll
                for (int bj = 0; bj < 2; ++bj) {
                    const size_t row = (size_t)(row0 + ai * HALF + m * 16); const int col = col0 + bj * HALF;
                    const u32x4 n_ = *(const u32x4*)(gp + row * ldg + col), d_ = *(const u32x4*)(gp + row * ldg + col + D);
                    float ln[8], ld[8];
                    ln[0] = __builtin_bit_cast(float, n_.x << 16); ln[1] = __builtin_bit_cast(float, n_.x & 0xffff0000u); ln[2] = __builtin_bit_cast(float, n_.y << 16); ln[3] = __builtin_bit_cast(float, n_.y & 0xffff0000u);
                    ln[4] = __builtin_bit_cast(float, n_.z << 16); ln[5] = __builtin_bit_cast(float, n_.z & 0xffff0000u); ln[6] = __builtin_bit_cast(float, n_.w << 16); ln[7] = __builtin_bit_cast(float, n_.w & 0xffff0000u);
                    ld[0] = __builtin_bit_cast(float, d_.x << 16); ld[1] = __builtin_bit_cast(float, d_.x & 0xffff0000u); ld[2] = __builtin_bit_cast(float, d_.y << 16); ld[3] = __builtin_bit_cast(float, d_.y & 0xffff0000u);
                    ld[4] = __builtin_bit_cast(float, d_.z << 16); ld[5] = __builtin_bit_cast(float, d_.z & 0xffff0000u); ld[6] = __builtin_bit_cast(float, d_.w << 16); ld[7] = __builtin_bit_cast(float, d_.w & 0xffff0000u);
#pragma unroll
                    for (int j = 0; j < 8; ++j) { const float r = (1.f + __builtin_amdgcn_exp2f(-1.4426950408889634f * ld[j])) * __builtin_amdgcn_rcpf(1.f + __builtin_amdgcn_exp2f(-1.4426950408889634f * ln[j]));
                        if (j < 4) acc[ai][bj][m][0][j] *= r; else acc[ai][bj][m][1][j - 4] *= r; }
                    if (bj == 1 && m == 3) __builtin_amdgcn_sched_barrier(0);
                }
    }
    __device__ __forceinline__ void operator()(const Acc& acc, const Unit& u, int wr, int wc, int fr, int fq, LAS unsigned char* ldsb) const {
        const int row0 = u.pm * BM + wr * 64 + fr, col0 = u.pn * BM + wc * 32 + fq * 8;
#pragma unroll
        for (int ai = 0; ai < 2; ++ai)
#pragma unroll
            for (int m = 0; m < 4; ++m)
#pragma unroll
                for (int bj = 0; bj < 2; ++bj) {
                    const size_t row = (size_t)(row0 + ai * HALF + m * 16); const int col = col0 + bj * HALF;
                    const u32x4 gw = *(const u32x4*)(gate + row * ldg + col + 2 * D);
                    f32x4 v0 = acc[ai][bj][m][0], v1 = acc[ai][bj][m][1];
                    v0[0] *= sigm_f(__builtin_bit_cast(float, gw.x << 16)); v0[1] *= sigm_f(__builtin_bit_cast(float, gw.x & 0xffff0000u));
                    v0[2] *= sigm_f(__builtin_bit_cast(float, gw.y << 16)); v0[3] *= sigm_f(__builtin_bit_cast(float, gw.y & 0xffff0000u));
                    v1[0] *= sigm_f(__builtin_bit_cast(float, gw.z << 16)); v1[1] *= sigm_f(__builtin_bit_cast(float, gw.z & 0xffff0000u));
                    v1[2] *= sigm_f(__builtin_bit_cast(float, gw.w << 16)); v1[3] *= sigm_f(__builtin_bit_cast(float, gw.w & 0xffff0000u));
                    u32x4 w; w.x = pk2(v0[0], v0[1]); w.y = pk2(v0[2], v0[3]); w.z = pk2(v1[0], v1[1]); w.w = pk2(v1[2], v1[3]); *(u32x4*)(Obf + row * D + col) = w;
                    if (bj == 1 && m == 3) __builtin_amdgcn_sched_barrier(0);
                }
    }
};
struct EpiCmpFinish {
    static constexpr bool HOOK = false;
    bf16_t* O; const float* part; const float* bias; unsigned* flag; unsigned expect;
    __device__ __forceinline__ void operator()(const Acc& acc, const Unit& u, int wr, int wc, int fr, int fq, LAS unsigned char* ldsb) const {
        while (__hip_atomic_load(flag, __ATOMIC_RELAXED, __HIP_MEMORY_SCOPE_AGENT) < expect) __builtin_amdgcn_s_sleep(2);
        __builtin_amdgcn_fence(__ATOMIC_ACQUIRE, "agent");
        asm volatile("s_waitcnt vmcnt(0)" ::: "memory");
        const int row0 = u.pm * BM + wr * 64 + fr, col0 = u.pn * BM + wc * 32 + fq * 8;
#pragma unroll
        for (int bj = 0; bj < 2; ++bj) {
            const int col = col0 + bj * HALF;
            const f32x4 b0 = *(const f32x4*)(bias + col), b1 = *(const f32x4*)(bias + col + 4);
#pragma unroll
            for (int ai = 0; ai < 2; ++ai)
#pragma unroll
                for (int m = 0; m < 4; ++m) {
                    const size_t off = (size_t)(row0 + ai * HALF + m * 16) * 256 + col;
                    f32x4 v0 = acc[ai][bj][m][0] + b0 + *(const f32x4*)(part + off), v1 = acc[ai][bj][m][1] + b1 + *(const f32x4*)(part + off + 4);
#pragma unroll
                    for (int j = 0; j < 4; ++j) { v0[j] = gelu_tanh_f(v0[j]); v1[j] = gelu_tanh_f(v1[j]); }
                    u32x4 w; w.x = pk2(v0[0], v0[1]); w.y = pk2(v0[2], v0[3]); w.z = pk2(v1[0], v1[1]); w.w = pk2(v1[2], v1[3]);
                    *(u32x4*)(O + off) = w;
                    if (m & 1) __builtin_amdgcn_sched_barrier(0);
                }
        }
    }
};
}

constexpr size_t al256(size_t x) { return (x + 255) & ~(size_t)255; }
constexpr size_t WS_GU1 = 0;
constexpr size_t WS_DN1 = WS_GU1 + (size_t)2 * DFF * D * 2;
constexpr size_t WS_GU2 = WS_DN1 + (size_t)D * DFF * 2;
constexpr size_t WS_DN2 = WS_GU2 + (size_t)2 * DFF * D * 2;
constexpr size_t WS_WIN = WS_DN2 + (size_t)D * DFF * 2;
constexpr size_t WS_UQ  = WS_WIN + (size_t)ZW * D * 2;
constexpr size_t WS_UKV = WS_UQ + (size_t)1280 * 512 * 2;
constexpr size_t WS_W1K = WS_UKV + (size_t)1536 * 256 * 2;
constexpr size_t WS_W1V = WS_W1K + (size_t)256 * 4096 * 2;
constexpr size_t WS_W2K = WS_W1V + (size_t)256 * 4096 * 2;
constexpr size_t WS_W2V = WS_W2K + (size_t)256 * 256 * 2;
constexpr size_t WS_BRA = WS_W2V + (size_t)256 * 256 * 2;
constexpr size_t WS_BRB = WS_BRA + (size_t)D * 512 * 2;
constexpr size_t WS_BRC = WS_BRB + (size_t)D * 768 * 2;
constexpr size_t WS_WO  = WS_BRC + (size_t)D * 768 * 2;
constexpr size_t WS_X   = WS_WO + (size_t)D * D * 2;
constexpr size_t WS_H   = WS_X + (size_t)T * D * 4;
constexpr size_t WS_Z   = WS_H + (size_t)T * D * 2;
constexpr size_t WS_MB  = WS_Z + (size_t)T * ZW * 2;
constexpr size_t WS_CQN = WS_MB + (size_t)T * D * 4;
constexpr size_t WS_CKVN = WS_CQN + (size_t)T * 512 * 2;
constexpr size_t WS_QF  = WS_CKVN + (size_t)T * 256 * 2;
constexpr size_t WS_KVF = WS_QF + (size_t)T * 1152 * 2;
constexpr size_t WS_KCP = WS_KVF + (size_t)T * 1536 * 2;
constexpr size_t WS_VCP = WS_KCP + (size_t)8 * SEQ * 128 * 2;
constexpr size_t WS_H1K = WS_VCP + (size_t)8 * SEQ * 128 * 2 + 8192;
constexpr size_t WS_H1V = WS_H1K + (size_t)1024 * 256 * 2;
constexpr size_t WS_KCMP = WS_H1V + (size_t)1024 * 256 * 2;
constexpr size_t WS_VCMP = WS_KCMP + (size_t)1024 * 128 * 4;
constexpr size_t WS_BPART = WS_VCMP + (size_t)1024 * 128 * 4;
constexpr size_t WS_BIAS = WS_BPART + (size_t)2 * 64 * 256 * 4;
constexpr size_t WS_KMP = WS_BIAS + (size_t)2 * 256 * 4;
constexpr size_t WS_KM  = WS_KMP + (size_t)256 * 512 * 4;
constexpr size_t WS_SELB = WS_KM + (size_t)32 * 512 * 4;
constexpr size_t WS_OC  = WS_SELB + (size_t)8 * SEQ * 4;
constexpr size_t WS_YA  = WS_OC + (size_t)T * 768 * 4;
constexpr size_t WS_YB  = WS_YA + (size_t)T * 512 * 2;
constexpr size_t WS_YC  = WS_YB + (size_t)T * 768 * 2;
constexpr size_t WS_COSH = WS_YC + (size_t)T * 768 * 2;
constexpr size_t WS_SINH = WS_COSH + (size_t)SEQ * 64 * 4;
constexpr size_t WS_COSR = WS_SINH + (size_t)SEQ * 64 * 4;
constexpr size_t WS_SINR = WS_COSR + (size_t)SEQ * 32 * 4;
constexpr size_t WS_BAR = WS_SINR + (size_t)SEQ * 32 * 4;
constexpr size_t WS_H1P = WS_BAR + 256;
constexpr size_t WS_SSP = WS_H1P + (size_t)2 * 1024 * 256 * 4;
constexpr size_t WS_XB = WS_SSP + (size_t)T * 8 * 4;
constexpr size_t WS_END0 = WS_XB + 16384;

__device__ __forceinline__ int conv_row(int kind, int n) {
    if (kind == 1) return ((n >> 7) << 8) + (n & 127);
    if (kind == 2) return ((n >> 7) << 8) + 128 + (n & 127);
    if (kind == 3) return n < 4690 ? n : n + (Z_MERGE - 4690);
    return n;
}
struct ConvDesc { const float* W; bf16_t* WT; const float* gain; int K, N, kind, ldw, koff, k0, n0; };
__device__ __forceinline__ void conv_load(const ConvDesc& d, int wave, int lane, f32x4 (&v)[8]) {
    const int n = d.n0 + 4 * lane;
    const float* src = d.W + (size_t)(d.k0 + wave * 8) * d.N + n;
    if ((d.N & 3) == 0) {
        const bool ok = n < d.N;
#pragma unroll
        for (int r = 0; r < 8; ++r) v[r] = ok ? *(const f32x4*)(src + (size_t)r * d.N) : (f32x4){0.f, 0.f, 0.f, 0.f};
    } else {
#pragma unroll
        for (int r = 0; r < 8; ++r)
#pragma unroll
            for (int e = 0; e < 4; ++e) v[r][e] = (n + e < d.N) ? src[(size_t)r * d.N + e] : 0.f;
    }
    if (d.gain) {
#pragma unroll
        for (int r = 0; r < 8; ++r) v[r] = v[r] * d.gain[d.k0 + wave * 8 + r];
    }
}
__device__ __forceinline__ void conv_lds_write(LAS float* tile, int wave, int lane, const f32x4 (&v)[8]) {
#pragma unroll
    for (int r = 0; r < 8; ++r)
#pragma unroll
        for (int e = 0; e < 4; ++e) tile[(wave * 8 + r) * 257 + 4 * lane + e] = v[r][e];
}
__device__ __forceinline__ void conv_store(const ConvDesc& d, const LAS float* tile, int tid) {
    const int c = tid & 7;
#pragma unroll
    for (int j = 0; j < 4; ++j) { const int nl = (tid >> 3) + 64 * j; const LAS float* s = tile + (8 * c) * 257 + nl;
        u32x4 o; o.x = pk2(s[0 * 257], s[1 * 257]); o.y = pk2(s[2 * 257], s[3 * 257]); o.z = pk2(s[4 * 257], s[5 * 257]); o.w = pk2(s[6 * 257], s[7 * 257]);
        if (d.n0 + nl < d.N) *(u32x4*)(d.WT + (size_t)conv_row(d.kind, d.n0 + nl) * d.ldw + d.koff + d.k0 + 8 * c) = o; }
}
constexpr int conv_items(int K, int N) { return (K / 64) * ((N + 255) / 256); }

struct ConvTab { int idx, K, N, off256, kind, end, ldw, koff; };
constexpr int CI_G = conv_items(D, DFF), CI_D = conv_items(DFF, D), CI_IN = conv_items(D, IN_COLS), CI_UQ = conv_items(512, 1152), CI_UKV = conv_items(256, 1536),
              CI_W1 = conv_items(4096, 256), CI_W2 = conv_items(256, 128), CI_BA = conv_items(512, D), CI_BB = conv_items(768, D), CI_WO = conv_items(D, D);
constexpr int CE0 = CI_G, CE1 = CE0 + CI_G, CE2 = CE1 + CI_D, CE3 = CE2 + CI_G, CE4 = CE3 + CI_G, CE5 = CE4 + CI_D, CE6 = CE5 + CI_IN, CE7 = CE6 + CI_UQ, CE8 = CE7 + CI_UKV,
              CE9 = CE8 + CI_W1, CE10 = CE9 + CI_W1, CE11 = CE10 + CI_W2, CE12 = CE11 + CI_W2, CE13 = CE12 + CI_BA, CE14 = CE13 + CI_BB, CE15 = CE14 + CI_BB, CE16 = CE15 + CI_WO;
constexpr int CONV_NITEMS = CE16;
__constant__ ConvTab CONV_TAB[17] = {
    {2, D, DFF, (int)(WS_GU1 / 256), 1, CE0, D, 0}, {3, D, DFF, (int)(WS_GU1 / 256), 2, CE1, D, 0}, {4, DFF, D, (int)(WS_DN1 / 256), 0, CE2, DFF, 0},
    {22, D, DFF, (int)(WS_GU2 / 256), 1, CE3, D, 0}, {23, D, DFF, (int)(WS_GU2 / 256), 2, CE4, D, 0}, {24, DFF, D, (int)(WS_DN2 / 256), 0, CE5, DFF, 0},
    {6, D, IN_COLS, (int)(WS_WIN / 256), 3, CE6, D, 0}, {8, 512, 1152, (int)(WS_UQ / 256), 0, CE7, 512, 0}, {10, 256, 1536, (int)(WS_UKV / 256), 0, CE8, 256, 0},
    {12, 4096, 256, (int)(WS_W1K / 256), 0, CE9, 4096, 0}, {15, 4096, 256, (int)(WS_W1V / 256), 0, CE10, 4096, 0}, {13, 256, 128, (int)(WS_W2K / 256), 0, CE11, 256, 0}, {16, 256, 128, (int)(WS_W2V / 256), 0, CE12, 256, 0},
    {17, 512, D, (int)(WS_BRA / 256), 0, CE13, 2048, 0}, {18, 768, D, (int)(WS_BRA / 256), 0, CE14, 2048, 512}, {19, 768, D, (int)(WS_BRA / 256), 0, CE15, 2048, 1280}, {20, D, D, (int)(WS_WO / 256), 0, CE16, D, 0}};
static_assert(WS_GU1 % 256 == 0 && WS_DN1 % 256 == 0 && WS_GU2 % 256 == 0 && WS_DN2 % 256 == 0 && WS_WIN % 256 == 0 && WS_UQ % 256 == 0 && WS_UKV % 256 == 0 && WS_W1K % 256 == 0 && WS_W1V % 256 == 0 &&
              WS_W2K % 256 == 0 && WS_W2V % 256 == 0 && WS_BRA % 256 == 0 && WS_BRB % 256 == 0 && WS_BRC % 256 == 0 && WS_WO % 256 == 0, "conversion table offsets");

__device__ __forceinline__ void rms_row_bf16(const float* xrow, const float* g, bf16_t* orow, int lane) {
    const f32x4* xr = (const f32x4*)xrow + lane; const f32x4* gr = (const f32x4*)g + lane;
    f32x4 v[8]; float s = 0.f;
#pragma unroll
    for (int j = 0; j < 8; ++j) { v[j] = xr[64 * j]; s += (v[j].x * v[j].x + v[j].y * v[j].y) + (v[j].z * v[j].z + v[j].w * v[j].w); }
    const float rstd = 1.f / sqrtf(wave_sum(s) * (1.f / D) + 1e-6f);
    u32x2* o8 = (u32x2*)orow + lane;
#pragma unroll
    for (int j = 0; j < 8; ++j) { const f32x4 gg = gr[64 * j]; u32x2 w; w.x = pk2(v[j].x * rstd * gg.x, v[j].y * rstd * gg.y); w.y = pk2(v[j].z * rstd * gg.z, v[j].w * rstd * gg.w); o8[64 * j] = w; }
}
__device__ __forceinline__ float rms_load_bf16row(const bf16_t* xrow, int lane, float (&v)[4][8]) {
    float s = 0.f;
#pragma unroll
    for (int j = 0; j < 4; ++j) { const u32x4 w = *((const u32x4*)xrow + lane + 64 * j);
        v[j][0] = __builtin_bit_cast(float, w.x << 16); v[j][1] = __builtin_bit_cast(float, w.x & 0xffff0000u); v[j][2] = __builtin_bit_cast(float, w.y << 16); v[j][3] = __builtin_bit_cast(float, w.y & 0xffff0000u);
        v[j][4] = __builtin_bit_cast(float, w.z << 16); v[j][5] = __builtin_bit_cast(float, w.z & 0xffff0000u); v[j][6] = __builtin_bit_cast(float, w.w << 16); v[j][7] = __builtin_bit_cast(float, w.w & 0xffff0000u);
#pragma unroll
        for (int i = 0; i < 8; ++i) s += v[j][i] * v[j][i]; }
    return 1.f / sqrtf(wave_sum(s) * (1.f / D) + 1e-6f);
}
__device__ __forceinline__ void rms_xrow_bf16(const bf16_t* xrow, const float* g, bf16_t* orow, int lane) {
    float v[4][8]; const float rstd = rms_load_bf16row(xrow, lane, v);
#pragma unroll
    for (int j = 0; j < 4; ++j) { const float* gp = g + (lane + 64 * j) * 8; const f32x4 g0 = *(const f32x4*)gp, g1 = *(const f32x4*)(gp + 4);
        u32x4 o; o.x = pk2(v[j][0] * rstd * g0[0], v[j][1] * rstd * g0[1]); o.y = pk2(v[j][2] * rstd * g0[2], v[j][3] * rstd * g0[3]);
        o.z = pk2(v[j][4] * rstd * g1[0], v[j][5] * rstd * g1[1]); o.w = pk2(v[j][6] * rstd * g1[2], v[j][7] * rstd * g1[3]);
        *((u32x4*)orow + lane + 64 * j) = o; }
}
__device__ __forceinline__ void rms_xrow_f32(const bf16_t* xrow, const float* g, float* orow, int lane) {
    float v[4][8]; const float rstd = rms_load_bf16row(xrow, lane, v);
#pragma unroll
    for (int j = 0; j < 4; ++j) { const float* gp = g + (lane + 64 * j) * 8; const f32x4 g0 = *(const f32x4*)gp, g1 = *(const f32x4*)(gp + 4); float* op = orow + (lane + 64 * j) * 8;
        *(f32x4*)op = (f32x4){v[j][0] * rstd * g0[0], v[j][1] * rstd * g0[1], v[j][2] * rstd * g0[2], v[j][3] * rstd * g0[3]};
        *(f32x4*)(op + 4) = (f32x4){v[j][4] * rstd * g1[0], v[j][5] * rstd * g1[1], v[j][6] * rstd * g1[2], v[j][7] * rstd * g1[3]}; }
}
__device__ __forceinline__ void rms_row_f32(const float* xrow, const float* g, float* orow, int lane) {
    const f32x4* xr = (const f32x4*)xrow + lane; const f32x4* gr = (const f32x4*)g + lane;
    f32x4 v[8]; float s = 0.f;
#pragma unroll
    for (int j = 0; j < 8; ++j) { v[j] = xr[64 * j]; s += (v[j].x * v[j].x + v[j].y * v[j].y) + (v[j].z * v[j].z + v[j].w * v[j].w); }
    const float rstd = 1.f / sqrtf(wave_sum(s) * (1.f / D) + 1e-6f);
    f32x4* o = (f32x4*)orow + lane;
#pragma unroll
    for (int j = 0; j < 8; ++j) { const f32x4 gg = gr[64 * j]; o[64 * j] = (f32x4){v[j].x * rstd * gg.x, v[j].y * rstd * gg.y, v[j].z * rstd * gg.z, v[j].w * rstd * gg.w}; }
}

namespace att {
typedef short s16x4 __attribute__((ext_vector_type(4)));
constexpr int VS = 272;
constexpr float NEGB = -1e30f;
__device__ __forceinline__ bf16x8 vtr2(LAS unsigned char* p0, LAS unsigned char* p1) {
    const s16x4 a = __builtin_amdgcn_ds_read_tr16_b64_v4i16((LAS s16x4*)p0);
    const s16x4 b = __builtin_amdgcn_ds_read_tr16_b64_v4i16((LAS s16x4*)p1);
    return (bf16x8){a[0], a[1], a[2], a[3], b[0], b[1], b[2], b[3]};
}
__device__ __forceinline__ bf16x8 pack8(const float* v) {
    u32x4 w; w.x = pk2(v[0], v[1]); w.y = pk2(v[2], v[3]); w.z = pk2(v[4], v[5]); w.w = pk2(v[6], v[7]);
    return __builtin_bit_cast(bf16x8, w);
}
__device__ __forceinline__ void unpack8(const u32x4 w, float* v) {
    v[0] = __builtin_bit_cast(float, w.x << 16); v[1] = __builtin_bit_cast(float, w.x & 0xffff0000u);
    v[2] = __builtin_bit_cast(float, w.y << 16); v[3] = __builtin_bit_cast(float, w.y & 0xffff0000u);
    v[4] = __builtin_bit_cast(float, w.z << 16); v[5] = __builtin_bit_cast(float, w.z & 0xffff0000u);
    v[6] = __builtin_bit_cast(float, w.w << 16); v[7] = __builtin_bit_cast(float, w.w & 0xffff0000u);
}

struct Pass {
    const bf16_t* K1; const bf16_t* K2; const bf16_t* V; int ldk1, ldk2, ldv;
    int window, shift; float sc;
};

template <int NSLAB>
__device__ __forceinline__ void load_q(const bf16_t* qrow, int t_seq, int g4, const float* cosT, const float* sinT, float (&qv)[NSLAB][8]) {
#pragma unroll
    for (int s = 0; s < NSLAB; ++s) { const u32x4 w = *(const u32x4*)(qrow + s * 32 + g4 * 8); unpack8(w, qv[s]); }
    if (NSLAB == 4) {
#pragma unroll
        for (int s = 0; s < 2; ++s) {
            const float* cp = cosT + (size_t)t_seq * 64 + s * 32 + g4 * 8; const float* sp = sinT + (size_t)t_seq * 64 + s * 32 + g4 * 8;
            const f32x4 c0 = *(const f32x4*)cp, c1 = *(const f32x4*)(cp + 4), s0 = *(const f32x4*)sp, s1 = *(const f32x4*)(sp + 4);
#pragma unroll
            for (int i = 0; i < 8; ++i) { const float c = i < 4 ? c0[i & 3] : c1[i & 3], sn = i < 4 ? s0[i & 3] : s1[i & 3];
                const float lo = qv[s][i], hi = qv[s + 2][i]; qv[s][i] = lo * c - hi * sn; qv[s + 2][i] = hi * c + lo * sn; }
        }
    } else {
        const float* cp = cosT + (size_t)t_seq * 32 + g4 * 8; const float* sp = sinT + (size_t)t_seq * 32 + g4 * 8;
        const f32x4 c0 = *(const f32x4*)cp, c1 = *(const f32x4*)(cp + 4), s0 = *(const f32x4*)sp, s1 = *(const f32x4*)(sp + 4);
#pragma unroll
        for (int i = 0; i < 8; ++i) { const float c = i < 4 ? c0[i & 3] : c1[i & 3], sn = i < 4 ? s0[i & 3] : s1[i & 3];
            const float lo = qv[NSLAB - 2][i], hi = qv[NSLAB - 1][i]; qv[NSLAB - 2][i] = lo * c - hi * sn; qv[NSLAB - 1][i] = hi * c + lo * sn; }
    }
}

template <int NSLAB>
__device__ __forceinline__ void attn_tile(LAS unsigned char* Kb, int kb, bool nomask, int window, int shift, float sc, const bf16x8 (&qf)[NSLAB], unsigned bits, int t,
                                          f32x4 (&o)[8], float& m, float& l, int r16, int g4, int q4, int p4) {
    constexpr int KS = NSLAB * 64 + 16, VOFF = 64 * KS;
    constexpr int VB = NSLAB == 4 ? 4 : 2;
    LAS unsigned char* kbase = Kb + r16 * KS + g4 * 16;
    LAS unsigned char* vbase = Kb + VOFF + (g4 * 4 + q4) * VS + (4 * p4) * 2;
#define AT_SB __builtin_amdgcn_sched_barrier(0)
#define AT_RDK(dst, sub) do { _Pragma("unroll") for (int sl = 0; sl < NSLAB; ++sl) dst[sl] = *(const LAS bf16x8*)(kbase + (sub) * 16 * KS + sl * 64); } while (0)
#define AT_MMK(src, sub) do { s[sub] = (f32x4){0.f, 0.f, 0.f, 0.f}; _Pragma("unroll") for (int sl = 0; sl < NSLAB; ++sl) s[sub] = __builtin_amdgcn_mfma_f32_16x16x32_bf16(src[sl], qf[sl], s[sub], 0, 0, 0); } while (0)
#define AT_RDV(dst, dt0) do { _Pragma("unroll") for (int d = 0; d < VB; ++d) _Pragma("unroll") for (int s2 = 0; s2 < 2; ++s2) { LAS unsigned char* vp = vbase + s2 * 32 * VS + ((dt0) + d) * 32; dst[d * 2 + s2] = vtr2(vp, vp + 16 * VS); } } while (0)
#define AT_MMV(src, dt0) do { _Pragma("unroll") for (int d = 0; d < VB; ++d) _Pragma("unroll") for (int s2 = 0; s2 < 2; ++s2) o[(dt0) + d] = __builtin_amdgcn_mfma_f32_16x16x32_bf16(src[d * 2 + s2], pf[s2], o[(dt0) + d], 0, 0, 0); } while (0)
    f32x4 s[4];
    bf16x8 ka[NSLAB], kc[NSLAB], va[VB * 2], vb[VB * 2];
    AT_RDK(ka, 0); AT_SB;
    AT_RDK(kc, 1); AT_MMK(ka, 0); AT_SB;
    AT_RDK(ka, 2); AT_MMK(kc, 1); AT_SB;
    AT_RDK(kc, 3); AT_MMK(ka, 2); AT_SB;
    AT_RDV(va, 0); AT_MMK(kc, 3); AT_SB;
    float mx = NEGB;
    if (nomask) {
        const bool sel = ((bits >> (kb >> shift)) & 1u) != 0u;
        const float scm = sel ? sc : 0.f, bias = sel ? 0.f : NEGB;
#pragma unroll
        for (int sub = 0; sub < 4; ++sub)
#pragma unroll
            for (int j = 0; j < 4; ++j) { const float v = fmaf(s[sub][j], scm, bias); s[sub][j] = v; mx = fmaxf(mx, v); }
    } else {
        const bool sel = ((bits >> (kb >> shift)) & 1u) != 0u;
        const float scm = sel ? sc : 0.f, bias = sel ? 0.f : NEGB;
        const int rel = t - kb - g4 * 4, lo = rel - window;
#pragma unroll
        for (int sub = 0; sub < 4; ++sub)
#pragma unroll
            for (int j = 0; j < 4; ++j) { const int c = sub * 16 + j;
                const bool ok = (c <= rel) && (c > lo);
                const float v = ok ? fmaf(s[sub][j], scm, bias) : NEGB; s[sub][j] = v; mx = fmaxf(mx, v); }
    }
    mx = xmax4(mx);
    const float mn = fmaxf(m, mx), alpha = __builtin_amdgcn_exp2f(m - mn); m = mn;
    const float mne = fmaxf(mn, -1e20f);
    float ls = 0.f;
#pragma unroll
    for (int sub = 0; sub < 4; ++sub)
#pragma unroll
        for (int j = 0; j < 4; ++j) { const float p = __builtin_amdgcn_exp2f(s[sub][j] - mne); s[sub][j] = p; ls += p; }
    l = l * alpha + ls;
    if (__any(alpha != 1.f)) {
#pragma unroll
        for (int dt = 0; dt < 8; ++dt) o[dt] = o[dt] * alpha;
    }
    bf16x8 pf[2];
#pragma unroll
    for (int s2 = 0; s2 < 2; ++s2) { u32x4 w; w.x = pk2(s[2 * s2][0], s[2 * s2][1]); w.y = pk2(s[2 * s2][2], s[2 * s2][3]); w.z = pk2(s[2 * s2 + 1][0], s[2 * s2 + 1][1]); w.w = pk2(s[2 * s2 + 1][2], s[2 * s2 + 1][3]);
        pf[s2] = __builtin_bit_cast(bf16x8, w); }
    AT_SB;
    if (VB == 4) {
        AT_RDV(vb, 4); AT_MMV(va, 0); AT_SB;
        AT_MMV(vb, 4); AT_SB;
    } else {
        AT_RDV(vb, 2); AT_MMV(va, 0); AT_SB;
        AT_RDV(va, 4); AT_MMV(vb, 2); AT_SB;
        AT_RDV(vb, 6); AT_MMV(va, 4); AT_SB;
        AT_MMV(vb, 6); AT_SB;
    }
#undef AT_SB
#undef AT_RDK
#undef AT_MMK
#undef AT_RDV
#undef AT_MMV
}

template <int NSLAB>
__device__ __forceinline__ void attn_pass(LAS unsigned char* lds, const Pass P, int b, int q0, int kt_lo, int kt_hi, const bf16x8 (&qf)[NSLAB], unsigned bits, int t,
                                          f32x4 (&o)[8], float& l_out, int tid, int wave, int lane) {
    constexpr int KS = NSLAB * 64 + 16;
    constexpr int VOFF = 64 * KS, BUF = VOFF + 64 * VS;
    const int r16 = lane & 15, g4 = lane >> 4, q4 = r16 >> 2, p4 = r16 & 3;
    const int tmin = q0 + wave * 16, tmax = tmin + 15;
    float m = NEGB, l = 0.f;
    { float z0 = 0.f; asm volatile("" : "+v"(z0));
#pragma unroll
      for (int dt = 0; dt < 8; ++dt) o[dt] = (f32x4){z0, z0, z0, z0}; }
    u32x4 rk1[4], rv[4], rk2[2];
#pragma unroll
    for (int i = 0; i < 2; ++i) rk2[i] = (u32x4){0u, 0u, 0u, 0u};
#define ATT_LOAD2(kt) do { \
        _Pragma("unroll") for (int i = 0; i < 4; ++i) { const int c = tid + i * 512, row = c >> 4, ch = c & 15; int key = (kt) * 64 + row; key = key > SEQ - 1 ? SEQ - 1 : key; const size_t rowg = (size_t)b * SEQ + key; \
            rk1[i] = *(const u32x4*)(P.K1 + rowg * P.ldk1 + ch * 8); rv[i] = *(const u32x4*)(P.V + rowg * P.ldv + ch * 8); } \
        if (NSLAB == 6) { _Pragma("unroll") for (int i = 0; i < 2; ++i) { const int c = tid + i * 512, row = c >> 3, ch = c & 7; int key = (kt) * 64 + row; key = key > SEQ - 1 ? SEQ - 1 : key; \
            rk2[i] = *(const u32x4*)(P.K2 + ((size_t)b * SEQ + key) * P.ldk2 + ch * 8); } } } while (0)
#define ATT_STORE2() do { \
        _Pragma("unroll") for (int i = 0; i < 4; ++i) { const int c = tid + i * 512, row = c >> 4, ch = c & 15; LAS unsigned char* B_ = lds + (row >> 6) * BUF; \
            *(LAS u32x4*)(B_ + (row & 63) * KS + ch * 16) = rk1[i]; *(LAS u32x4*)(B_ + VOFF + (row & 63) * VS + ch * 16) = rv[i]; } \
        if (NSLAB == 6) { _Pragma("unroll") for (int i = 0; i < 2; ++i) { const int c = tid + i * 512, row = c >> 3, ch = c & 7; \
            *(LAS u32x4*)(lds + (row >> 6) * BUF + (row & 63) * KS + 256 + ch * 16) = rk2[i]; } } } while (0)
#define ATT_BAR do { asm volatile("s_waitcnt lgkmcnt(0)" ::: "memory"); __builtin_amdgcn_s_barrier(); asm volatile("" ::: "memory"); } while (0)
#define ATT_ACTIVE(kb) ((kb) <= tmax && (kb) + 63 > tmin - P.window)
#define ATT_NOMASK(kb) ((kb) + 63 <= tmin && (kb) > tmax - P.window)
    const int nt = kt_hi - kt_lo + 1, ns = (nt + 1) >> 1;
    ATT_LOAD2(kt_lo);
    for (int is = 0; is < ns; ++is) {
        const int kt = kt_lo + 2 * is;
        ATT_BAR;
        ATT_STORE2();
        ATT_BAR;
        if (is + 1 < ns) ATT_LOAD2(kt + 2);
        { const int kb = kt * 64; if (ATT_ACTIVE(kb)) attn_tile<NSLAB>(lds, kb, ATT_NOMASK(kb), P.window, P.shift, P.sc, qf, bits, t, o, m, l, r16, g4, q4, p4); }
        if (kt + 1 <= kt_hi) { const int kb = (kt + 1) * 64; if (ATT_ACTIVE(kb)) attn_tile<NSLAB>(lds + BUF, kb, ATT_NOMASK(kb), P.window, P.shift, P.sc, qf, bits, t, o, m, l, r16, g4, q4, p4); }
    }
#undef ATT_LOAD2
#undef ATT_STORE2
#undef ATT_BAR
#undef ATT_ACTIVE
#undef ATT_NOMASK
    l_out = l;
}
__device__ __forceinline__ float row_total(float l) { return xsum4(l); }

__device__ __forceinline__ void moba_unit(LAS unsigned char* lds, unsigned char* ws, int u) {
    int tid = threadIdx.x; asm volatile("" : "+v"(tid));
    const int lane = tid & 63, wave = __builtin_amdgcn_readfirstlane(tid >> 6), r16 = lane & 15, g4 = lane >> 4;
    const int qt = 15 - u / 16, bh = u % 16, b = bh >> 2, h = bh & 3, q0 = qt * 128;
    const bf16_t* Z = (const bf16_t*)(ws + WS_Z);
    const int t = q0 + wave * 16 + r16;
    float qv[4][8];
    load_q<4>(Z + (size_t)(b * SEQ + t) * ZW + Z_AQ + h * 128, t, g4, (const float*)(ws + WS_COSH), (const float*)(ws + WS_SINH), qv);
    const int own = q0 >> 8;
    unsigned bits;
    {
        const float* KM = (const float*)(ws + WS_KM) + (size_t)(b * 8) * 512 + h * 128;
        float gate[7];
#pragma unroll
        for (int n = 0; n < 7; ++n) { float a = 0.f;
            if (n < own) {
#pragma unroll
                for (int s = 0; s < 4; ++s) { const float* kp = KM + n * 512 + s * 32 + g4 * 8; const f32x4 k0 = *(const f32x4*)kp, k1 = *(const f32x4*)(kp + 4);
                    a += qv[s][0] * k0[0] + qv[s][1] * k0[1] + qv[s][2] * k0[2] + qv[s][3] * k0[3] + qv[s][4] * k1[0] + qv[s][5] * k1[1] + qv[s][6] * k1[2] + qv[s][7] * k1[3]; }
                a = xsum4(a);
            }
            gate[n] = a; }
        unsigned sel = 0u;
        if (own <= 3) sel = (1u << own) - 1u;
        else {
#pragma unroll
            for (int k = 0; k < 3; ++k) { float best = -3.0e38f; int bi = 0;
#pragma unroll
                for (int n = 0; n < 7; ++n) if (n < own && !((sel >> n) & 1u) && gate[n] > best) { best = gate[n]; bi = n; }
                sel |= 1u << bi; }
        }
        bits = sel | (1u << own);
    }
    bf16x8 qf[4];
#pragma unroll
    for (int s = 0; s < 4; ++s) qf[s] = pack8(qv[s]);
    Pass P; P.K1 = Z + Z_AK + h * 128; P.K2 = nullptr; P.V = Z + Z_AV + h * 128; P.ldk1 = ZW; P.ldk2 = 0; P.ldv = ZW; P.window = 1 << 30; P.shift = 8; P.sc = 0.08838834764831845f * 1.4426950408889634f;
    f32x4 o[8]; float l;
    attn_pass<4>(lds, P, b, q0, 0, (q0 + 127) >> 6, qf, bits, t, o, l, tid, wave, lane);
    const float inv = 1.f / fmaxf(row_total(l), 1e-30f);
    bf16_t* yrow = (bf16_t*)(ws + WS_YA) + (size_t)(b * SEQ + t) * 2048 + h * 128 + g4 * 4;
#pragma unroll
    for (int dt = 0; dt < 8; ++dt) { u32x2 w; w.x = pk2(o[dt][0] * inv, o[dt][1] * inv); w.y = pk2(o[dt][2] * inv, o[dt][3] * inv); *(u32x2*)(yrow + dt * 16) = w; }
}

__device__ __forceinline__ void mla_unit(LAS unsigned char* lds, unsigned char* ws, int u) {
    int tid = threadIdx.x; asm volatile("" : "+v"(tid));
    const int lane = tid & 63, wave = __builtin_amdgcn_readfirstlane(tid >> 6), r16 = lane & 15, g4 = lane >> 4;
    const int qt = 15 - u / 24, bh = u % 24, b = bh / 6, h = bh % 6, q0 = qt * 128;
    const int t = q0 + wave * 16 + r16;
    float qv[6][8];
    load_q<6>((const bf16_t*)(ws + WS_QF) + (size_t)(b * SEQ + t) * 1152 + h * 192, t, g4, (const float*)(ws + WS_COSR), (const float*)(ws + WS_SINR), qv);
    bf16x8 qf[6];
#pragma unroll
    for (int s = 0; s < 6; ++s) qf[s] = pack8(qv[s]);
    const bf16_t* KVF = (const bf16_t*)(ws + WS_KVF);
    Pass P; P.K1 = KVF + h * 256; P.K2 = (const bf16_t*)(ws + WS_Z) + Z_KR; P.V = KVF + h * 256 + 128; P.ldk1 = 1536; P.ldk2 = ZW; P.ldv = 1536; P.window = 1 << 30; P.shift = 6;
    P.sc = 0.07216878364870322f * 1.4426950408889634f;
    f32x4 o[8]; float l;
    attn_pass<6>(lds, P, b, q0, 0, (q0 + 127) >> 6, qf, 0xffffffffu, t, o, l, tid, wave, lane);
    const float inv = 1.f / fmaxf(row_total(l), 1e-30f);
    bf16_t* yrow = (bf16_t*)(ws + WS_YA) + (size_t)(b * SEQ + t) * 2048 + 512 + h * 128 + g4 * 4;
#pragma unroll
    for (int dt = 0; dt < 8; ++dt) { u32x2 w; w.x = pk2(o[dt][0] * inv, o[dt][1] * inv); w.y = pk2(o[dt][2] * inv, o[dt][3] * inv); *(u32x2*)(yrow + dt * 16) = w; }
}

__device__ __forceinline__ void nsa_unit(LAS unsigned char* lds, unsigned char* ws, int u) {
    int tid = threadIdx.x; asm volatile("" : "+v"(tid));
    const int lane = tid & 63, wave = __builtin_amdgcn_readfirstlane(tid >> 6), r16 = lane & 15, g4 = lane >> 4;
    const int qt = 15 - u / 24, bh = u % 24, b = bh / 6, hd = bh % 6, g = hd / 3, q0 = qt * 128;
    const bf16_t* Z = (const bf16_t*)(ws + WS_Z);
    const int t = q0 + wave * 16 + r16;
    const size_t trow = (size_t)(b * SEQ + t);
    float qv[4][8];
    load_q<4>(Z + trow * ZW + Z_NQ + hd * 128, t, g4, (const float*)(ws + WS_COSH), (const float*)(ws + WS_SINH), qv);
    bf16x8 qf[4];
#pragma unroll
    for (int s = 0; s < 4; ++s) qf[s] = pack8(qv[s]);
    const float g1 = pg8::sigm_f(bf2f(Z[trow * ZW + Z_GATE + hd * 3 + 1])), g2 = pg8::sigm_f(bf2f(Z[trow * ZW + Z_GATE + hd * 3 + 2]));
    const unsigned selb = ((const unsigned*)(ws + WS_SELB))[(size_t)(b * 2 + g) * SEQ + t];
    f32x4 acc[8];
    {
        Pass P; P.K1 = Z + Z_KS + g * 128; P.K2 = nullptr; P.V = Z + Z_VS + g * 128; P.ldk1 = ZW; P.ldk2 = 0; P.ldv = ZW; P.window = 1 << 30; P.shift = 6; P.sc = 0.08838834764831845f * 1.4426950408889634f;
        f32x4 o[8]; float l;
        attn_pass<4>(lds, P, b, q0, 0, (q0 + 127) >> 6, qf, selb, t, o, l, tid, wave, lane);
        const float w = g1 / fmaxf(row_total(l), 1e-30f);
#pragma unroll
        for (int dt = 0; dt < 8; ++dt) acc[dt] = o[dt] * w;
    }
    {
        Pass P; P.K1 = Z + Z_KW + g * 128; P.K2 = nullptr; P.V = Z + Z_VW + g * 128; P.ldk1 = ZW; P.ldk2 = 0; P.ldv = ZW; P.window = 512; P.shift = 6; P.sc = 0.08838834764831845f * 1.4426950408889634f;
        f32x4 o[8]; float l;
        const int klo = q0 - 511 > 0 ? (q0 - 511) >> 6 : 0;
        attn_pass<4>(lds, P, b, q0, klo, (q0 + 127) >> 6, qf, 0xffffffffu, t, o, l, tid, wave, lane);
        const float w = g2 / fmaxf(row_total(l), 1e-30f);
#pragma unroll
        for (int dt = 0; dt < 8; ++dt) acc[dt] = acc[dt] + o[dt] * w;
    }
    const float* oc = (const float*)(ws + WS_OC) + trow * 768 + hd * 128 + g4 * 4;
    bf16_t* yrow = (bf16_t*)(ws + WS_YA) + trow * 2048 + 1280 + hd * 128 + g4 * 4;
#pragma unroll
    for (int dt = 0; dt < 8; ++dt) { const f32x4 c = *(const f32x4*)(oc + dt * 16); const f32x4 v = acc[dt] + c;
        u32x2 w; w.x = pk2(v[0], v[1]); w.y = pk2(v[2], v[3]); *(u32x2*)(yrow + dt * 16) = w; }
}

__device__ __forceinline__ void nsa_cmp_unit(LAS unsigned char* lds, unsigned char* ws, int u, bool stage) {
    int tid = threadIdx.x; asm volatile("" : "+v"(tid));
    const int lane = tid & 63, wave = __builtin_amdgcn_readfirstlane(tid >> 6), r16 = lane & 15, g4 = lane >> 4, q4 = r16 >> 2, p4 = r16 & 3;
    const int bg = u >> 6, b = bg >> 1, g = bg & 1, q0 = (u & 63) * 32;
    constexpr int KOFF = 0, VOFFC = 128 * VS, PBOFF = 2 * 128 * VS, PBS = 132, IMPOFF = PBOFF + 3 * 32 * PBS * 4;
    const float* cosT = (const float*)(ws + WS_COSH); const float* sinT = (const float*)(ws + WS_SINH);
    __syncthreads();
    if (stage) {
        const float* KC = (const float*)(ws + WS_KCMP) + (size_t)bg * 128 * 128; const float* VC = (const float*)(ws + WS_VCMP) + (size_t)bg * 128 * 128;
#pragma unroll
        for (int i = 0; i < 2; ++i) { const int c = tid + i * 512, n = c >> 3, ch = c & 7;
            int pos = 16 * n + 31; pos = pos > SEQ - 1 ? SEQ - 1 : pos;
            const float* kp = KC + n * 128 + ch * 8; float lo[8], hi[8], cs[8], sn[8];
            *(f32x4*)lo = *(const f32x4*)kp; *(f32x4*)(lo + 4) = *(const f32x4*)(kp + 4); *(f32x4*)hi = *(const f32x4*)(kp + 64); *(f32x4*)(hi + 4) = *(const f32x4*)(kp + 68);
            *(f32x4*)cs = *(const f32x4*)(cosT + pos * 64 + ch * 8); *(f32x4*)(cs + 4) = *(const f32x4*)(cosT + pos * 64 + ch * 8 + 4);
            *(f32x4*)sn = *(const f32x4*)(sinT + pos * 64 + ch * 8); *(f32x4*)(sn + 4) = *(const f32x4*)(sinT + pos * 64 + ch * 8 + 4);
            float a[8], bb[8];
#pragma unroll
            for (int j = 0; j < 8; ++j) { a[j] = lo[j] * cs[j] - hi[j] * sn[j]; bb[j] = hi[j] * cs[j] + lo[j] * sn[j]; }
            *(LAS bf16x8*)(lds + KOFF + n * VS + ch * 16) = pack8(a); *(LAS bf16x8*)(lds + KOFF + n * VS + 128 + ch * 16) = pack8(bb); }
#pragma unroll
        for (int i = 0; i < 4; ++i) { const int c = tid + i * 512, n = c >> 4, ch = c & 15; const float* vp = VC + n * 128 + ch * 8; float v[8];
            *(f32x4*)v = *(const f32x4*)vp; *(f32x4*)(v + 4) = *(const f32x4*)(vp + 4);
            *(LAS bf16x8*)(lds + VOFFC + n * VS + ch * 16) = pack8(v); }
    }
    __syncthreads();
    const bf16_t* Z = (const bf16_t*)(ws + WS_Z);
    if (wave < 6) {
        const int r = wave >> 1, qs = wave & 1, hd = g * 3 + r, t = q0 + qs * 16 + r16; const size_t trow = (size_t)(b * SEQ + t);
        float qv[4][8];
        load_q<4>(Z + trow * ZW + Z_NQ + hd * 128, t, g4, cosT, sinT, qv);
        bf16x8 qf[4];
#pragma unroll
        for (int s = 0; s < 4; ++s) qf[s] = pack8(qv[s]);
        f32x4 s[8];
#pragma unroll
        for (int sub = 0; sub < 8; ++sub) { s[sub] = (f32x4){0.f, 0.f, 0.f, 0.f};
#pragma unroll
            for (int sl = 0; sl < 4; ++sl) { const bf16x8 kf = *(const LAS bf16x8*)(lds + KOFF + (sub * 16 + r16) * VS + sl * 64 + g4 * 16);
                s[sub] = __builtin_amdgcn_mfma_f32_16x16x32_bf16(kf, qf[sl], s[sub], 0, 0, 0); } }
        const float sc = 0.08838834764831845f * 1.4426950408889634f;
        float mx = NEGB;
#pragma unroll
        for (int sub = 0; sub < 8; ++sub)
#pragma unroll
            for (int j = 0; j < 4; ++j) { const int n = sub * 16 + g4 * 4 + j; const bool ok = (16 * n + 31 <= t); const float v = ok ? s[sub][j] * sc : NEGB; s[sub][j] = v; mx = fmaxf(mx, v); }
        mx = xmax4(mx);
        float ls = 0.f;
#pragma unroll
        for (int sub = 0; sub < 8; ++sub)
#pragma unroll
            for (int j = 0; j < 4; ++j) { const float p = s[sub][j] > -1e29f ? __builtin_amdgcn_exp2f(s[sub][j] - mx) : 0.f; s[sub][j] = p; ls += p; }
        ls = row_total(ls);
        const float inv = 1.f / fmaxf(ls, 1e-30f);
        LAS float* pb = (LAS float*)(lds + PBOFF) + (size_t)(r * 32 + qs * 16 + r16) * PBS + g4 * 4;
#pragma unroll
        for (int sub = 0; sub < 8; ++sub) { s[sub] = s[sub] * inv; *(LAS f32x4*)(pb + sub * 16) = s[sub]; }
        f32x4 o[8];
        { float z0 = 0.f; asm volatile("" : "+v"(z0));
#pragma unroll
          for (int dt = 0; dt < 8; ++dt) o[dt] = (f32x4){z0, z0, z0, z0}; }
#pragma unroll
        for (int s2 = 0; s2 < 4; ++s2) { u32x4 w; w.x = pk2(s[2 * s2][0], s[2 * s2][1]); w.y = pk2(s[2 * s2][2], s[2 * s2][3]); w.z = pk2(s[2 * s2 + 1][0], s[2 * s2 + 1][1]); w.w = pk2(s[2 * s2 + 1][2], s[2 * s2 + 1][3]);
            const bf16x8 pf = __builtin_bit_cast(bf16x8, w);
#pragma unroll
            for (int dt = 0; dt < 8; ++dt) { LAS unsigned char* vp = lds + VOFFC + (s2 * 32 + g4 * 4 + q4) * VS + (dt * 16 + 4 * p4) * 2;
                const bf16x8 vf = vtr2(vp, vp + 16 * VS);
                o[dt] = __builtin_amdgcn_mfma_f32_16x16x32_bf16(vf, pf, o[dt], 0, 0, 0); } }
        const float g0 = pg8::sigm_f(bf2f(Z[trow * ZW + Z_GATE + hd * 3 + 0]));
        float* oc = (float*)(ws + WS_OC) + trow * 768 + hd * 128 + g4 * 4;
#pragma unroll
        for (int dt = 0; dt < 8; ++dt) *(f32x4*)(oc + dt * 16) = o[dt] * g0;
    }
    __syncthreads();
    {
        const LAS float* PB = (const LAS float*)(lds + PBOFF); LAS float* IMP = (LAS float*)(lds + IMPOFF);
#pragma unroll
        for (int k = 0; k < 2; ++k) { const int idx = tid + 512 * k, q = idx >> 5, j = idx & 31, t = q0 + q, cur = t >> 6;
            const int n0 = 4 * j - 1 < 0 ? 0 : 4 * j - 1, n1 = 4 * j + 3 > 126 ? 126 : 4 * j + 3;
            float a = 0.f;
            for (int r = 0; r < 3; ++r) for (int n = n0; n <= n1; ++n) a += PB[(r * 32 + q) * PBS + n];
            if (j == 0 || j == cur || j == cur - 1) a = 1e9f;
            if (j > cur) a = -__builtin_inff();
            IMP[q * 32 + j] = a; }
    }
    __syncthreads();
    {
        const LAS float* IMP = (const LAS float*)(lds + IMPOFF);
#pragma unroll
        for (int k = 0; k < 2; ++k) { const int idx = tid + 512 * k, q = idx >> 5, j = idx & 31; const float me = IMP[q * 32 + j];
            int rank = 0;
            for (int jj = 0; jj < 32; ++jj) { const float o = IMP[q * 32 + jj]; rank += (o > me || (o == me && jj < j)) ? 1 : 0; }
            const unsigned long long bal = __ballot(rank < 16);
            if ((lane & 31) == 0) ((unsigned*)(ws + WS_SELB))[(size_t)bg * SEQ + q0 + q] = (unsigned)(bal >> (lane & 32)); }
    }
}
}

__device__ __forceinline__ void prep_unit(LAS unsigned char* lds, unsigned char* ws, const float* qn, const float* kvn, int u) {
    using att::unpack8;
    int tid = threadIdx.x; asm volatile("" : "+v"(tid));
    const int lane = tid & 63, wave = __builtin_amdgcn_readfirstlane(tid >> 6);
    bf16_t* Z = (bf16_t*)(ws + WS_Z);
    const float* cosH = (const float*)(ws + WS_COSH); const float* sinH = (const float*)(ws + WS_SINH);
    const float* cosR = (const float*)(ws + WS_COSR); const float* sinR = (const float*)(ws + WS_SINR);
    float ksum[8];
#pragma unroll
    for (int i = 0; i < 8; ++i) ksum[i] = 0.f;
    for (int k = 0; k < 4; ++k) {
        const int tok = u * 32 + wave * 4 + k, sq = tok & (SEQ - 1), b = tok >> 11;
        bf16_t* zr = Z + (size_t)tok * ZW;
        float cs[8], sn[8];
        { const float* cp = cosH + sq * 64 + (lane & 7) * 8; const float* sp = sinH + sq * 64 + (lane & 7) * 8;
          *(f32x4*)cs = *(const f32x4*)cp; *(f32x4*)(cs + 4) = *(const f32x4*)(cp + 4); *(f32x4*)sn = *(const f32x4*)sp; *(f32x4*)(sn + 4) = *(const f32x4*)(sp + 4); }
        const bool hi = (lane & 8) != 0;
        {
            float v[8], o[8]; unpack8(*(const u32x4*)(zr + Z_AK + lane * 8), v);
#pragma unroll
            for (int i = 0; i < 8; ++i) { const float pr = __shfl_xor(v[i], 8); o[i] = hi ? v[i] * cs[i] + pr * sn[i] : v[i] * cs[i] - pr * sn[i]; ksum[i] += o[i]; }
            *(bf16x8*)(zr + Z_AK + lane * 8) = att::pack8(o);
        }
        {
            bf16_t* p = zr + (lane < 32 ? Z_KS : Z_KW) + (lane & 31) * 8;
            float v[8], o[8]; unpack8(*(const u32x4*)p, v);
#pragma unroll
            for (int i = 0; i < 8; ++i) { const float pr = __shfl_xor(v[i], 8); o[i] = hi ? v[i] * cs[i] + pr * sn[i] : v[i] * cs[i] - pr * sn[i]; }
            *(bf16x8*)p = att::pack8(o);
        }
        {
            const int l8 = lane & 7; bf16_t* p = zr + Z_KR + l8 * 8;
            float v[8], o[8], c2[8], s2[8]; unpack8(*(const u32x4*)p, v);
            { const float* cp = cosR + sq * 32 + (l8 & 3) * 8; const float* sp = sinR + sq * 32 + (l8 & 3) * 8;
              *(f32x4*)c2 = *(const f32x4*)cp; *(f32x4*)(c2 + 4) = *(const f32x4*)(cp + 4); *(f32x4*)s2 = *(const f32x4*)sp; *(f32x4*)(s2 + 4) = *(const f32x4*)(sp + 4); }
            const bool h2 = (l8 & 4) != 0;
#pragma unroll
            for (int i = 0; i < 8; ++i) { const float pr = __shfl_xor(v[i], 4); o[i] = h2 ? v[i] * c2[i] + pr * s2[i] : v[i] * c2[i] - pr * s2[i]; }
            if (lane < 8) *(bf16x8*)p = att::pack8(o);
        }
        {
            float v[8], o[8]; unpack8(*(const u32x4*)(zr + Z_CQ + lane * 8), v);
            float ss = 0.f;
#pragma unroll
            for (int i = 0; i < 8; ++i) ss += v[i] * v[i];
            const float rstd = 1.f / sqrtf(wave_sum(ss) * (1.f / 512.f) + 1e-6f);
            const f32x4 g0 = *(const f32x4*)(qn + lane * 8), g1 = *(const f32x4*)(qn + lane * 8 + 4);
#pragma unroll
            for (int i = 0; i < 8; ++i) o[i] = v[i] * rstd * (i < 4 ? g0[i & 3] : g1[i & 3]);
            *(bf16x8*)((bf16_t*)(ws + WS_CQN) + (size_t)tok * 512 + lane * 8) = att::pack8(o);
            const int l5 = lane & 31;
            unpack8(*(const u32x4*)(zr + Z_CKV + l5 * 8), v);
            ss = 0.f;
#pragma unroll
            for (int i = 0; i < 8; ++i) ss += v[i] * v[i];
            const float rstd2 = 1.f / sqrtf(wave_sum(ss) * 0.5f * (1.f / 256.f) + 1e-6f);
            const f32x4 h0 = *(const f32x4*)(kvn + l5 * 8), h1 = *(const f32x4*)(kvn + l5 * 8 + 4);
#pragma unroll
            for (int i = 0; i < 8; ++i) o[i] = v[i] * rstd2 * (i < 4 ? h0[i & 3] : h1[i & 3]);
            if (lane < 32) *(bf16x8*)((bf16_t*)(ws + WS_CKVN) + (size_t)tok * 256 + l5 * 8) = att::pack8(o);
        }
        {
            const u32x4 w = *(const u32x4*)(zr + Z_KC + lane * 8);
            const int which = lane >> 5, g = (lane >> 4) & 1, d = (lane & 15) * 8;
            bf16_t* dst = (bf16_t*)(ws + (which ? WS_VCP : WS_KCP)) + ((size_t)(b * 2 + g) * SEQ + sq) * 128 + d;
            *(u32x4*)dst = w;
        }
    }
    LAS float* red = (LAS float*)lds;
    __syncthreads();
#pragma unroll
    for (int i = 0; i < 8; ++i) red[wave * 512 + lane * 8 + i] = ksum[i];
    __syncthreads();
    { float a = 0.f;
#pragma unroll
      for (int w = 0; w < 8; ++w) a += red[w * 512 + tid];
      ((float*)(ws + WS_KMP))[(size_t)u * 512 + tid] = a; }
}

struct AttOrder { unsigned short u[640]; };
constexpr AttOrder make_att_order() {
    AttOrder t{}; int n = 0;
    for (int c = 50; c >= 4; --c) {
        if ((c - 5) % 3 == 0 && (c - 5) / 3 <= 15 && c >= 5) { const int qt = (c - 5) / 3; for (int i = 0; i < 24; ++i) t.u[n++] = (unsigned short)((15 - qt) * 24 + i); }
        if ((c - 4) % 2 == 0 && (c - 4) / 2 <= 15) { const int qt = (c - 4) / 2; for (int i = 0; i < 16; ++i) t.u[n++] = (unsigned short)(0x1000 | ((15 - qt) * 16 + i)); }
    }
    return t;
}
__constant__ AttOrder ATT_ORDER = make_att_order();

__device__ __forceinline__ void gbar(unsigned* ctr, unsigned& target, unsigned G) {
    asm volatile("s_waitcnt vmcnt(0) lgkmcnt(0)" ::: "memory");
    __syncthreads();
    target += G;
    if (threadIdx.x < 64) {
        if (threadIdx.x == 0) {
            __builtin_amdgcn_fence(__ATOMIC_RELEASE, "agent");
            asm volatile("s_waitcnt vmcnt(0)" ::: "memory");
            __hip_atomic_fetch_add(ctr, 1u, __ATOMIC_RELAXED, __HIP_MEMORY_SCOPE_AGENT);
            while (__hip_atomic_load(ctr, __ATOMIC_RELAXED, __HIP_MEMORY_SCOPE_AGENT) < target) __builtin_amdgcn_s_sleep(2);
        }
        __builtin_amdgcn_fence(__ATOMIC_ACQUIRE, "agent");
        asm volatile("s_waitcnt vmcnt(0)" ::: "memory");
    }
    __syncthreads();
}

#define XB_TMO      128
#define XB_XCNT(j)  (256  + 64 * (j))
#define XB_XSUB(j)  (1280 + 64 * (j))
#define XB_XGEN(j)  (2304 + 64 * (j))
#define XB_TOP      3328
#define XB_TOPGEN   3392
#define XCD_BAR_WORDS 3456
#define XB_SPIN_CAP (1u << 18)
__device__ __forceinline__ unsigned xb_ld(unsigned* p)              { return __hip_atomic_load(p, __ATOMIC_RELAXED, __HIP_MEMORY_SCOPE_AGENT); }
__device__ __forceinline__ unsigned xb_add(unsigned* p, unsigned v) { return __hip_atomic_fetch_add(p, v, __ATOMIC_RELAXED, __HIP_MEMORY_SCOPE_AGENT); }
__device__ __forceinline__ unsigned xb_xcc_id() { return (unsigned)__builtin_amdgcn_s_getreg((3 << 11) | 20) & 0xFu; }
#define XB_SPIN(cond, bar) do { unsigned _sp = 0; while (cond) { __builtin_amdgcn_s_sleep(1); \
    if ((++_sp & 255u) == 0u) { if (xb_ld(&(bar)[XB_TMO])) break; if (_sp > XB_SPIN_CAP) { atomicAdd(&(bar)[XB_TMO], 1u); break; } } } } while (0)
__device__ __forceinline__ void xcd_barrier_complete(unsigned* bar, unsigned x, unsigned& nloc, unsigned& nx) {
    const unsigned G = gridDim.x * gridDim.y * gridDim.z;
    unsigned sum, cnt, mine, sp = 0u;
    for (;;) {
        sum = 0u; cnt = 0u; mine = 0u;
#pragma unroll
        for (unsigned j = 0; j < 16; ++j) { const unsigned c = xb_ld(&bar[XB_XCNT(j)]); sum += c; cnt += (c > 0u) ? 1u : 0u; mine = (j == x) ? c : mine; }
        if (sum == G) break;
        __builtin_amdgcn_s_sleep(1);
        if ((++sp & 255u) == 0u) { if (xb_ld(&bar[XB_TMO])) break; if (sp > XB_SPIN_CAP) { atomicAdd(&bar[XB_TMO], 1u); break; } }
    }
    nloc = mine > 0u ? mine : 1u; nx = cnt > 0u ? cnt : 1u;
}
__device__ __forceinline__ void xcd_barrier(unsigned* bar, volatile LAS unsigned* st) {
    asm volatile("s_waitcnt vmcnt(0) lgkmcnt(0)" ::: "memory");
    __syncthreads();
    if (threadIdx.x == 0) {
        const unsigned x = xb_xcc_id();
        __builtin_amdgcn_s_waitcnt(0);
        unsigned nloc = st[0], nx = st[1];
        if (nloc == 0u) { xcd_barrier_complete(bar, x, nloc, nx); st[0] = nloc; st[1] = nx; }
        const unsigned old = xb_add(&bar[XB_XSUB(x)], 1u);
        const unsigned gen = old / nloc;
        if (old + 1u == (gen + 1u) * nloc) {
            __builtin_amdgcn_fence(__ATOMIC_RELEASE, "agent");
            asm volatile("s_waitcnt vmcnt(0)" ::: "memory");
            const unsigned og = xb_add(&bar[XB_TOP], 1u);
            const unsigned tg = og / nx;
            if (og + 1u == (tg + 1u) * nx) xb_add(&bar[XB_TOPGEN], 1u);
            else XB_SPIN(xb_ld(&bar[XB_TOPGEN]) == tg, bar);
            __builtin_amdgcn_fence(__ATOMIC_ACQUIRE, "agent");
            xb_add(&bar[XB_XGEN(x)], 1u);
            asm volatile("s_waitcnt vmcnt(0)" ::: "memory");
        } else {
            XB_SPIN(xb_ld(&bar[XB_XGEN(x)]) == gen, bar);
            __builtin_amdgcn_fence(__ATOMIC_ACQUIRE, "agent");
            asm volatile("s_waitcnt vmcnt(0)" ::: "memory");
        }
    }
    __syncthreads();
}

struct Args { const float* in[26]; float* out; unsigned char* ws; };

__device__ __forceinline__ int opq(int v) { asm volatile("" : "+s"(v)); return v; }
__global__ void __launch_bounds__(NTHREADS, 2) mega_fwd(Args args) {
    extern __shared__ __attribute__((aligned(16))) unsigned char lds_raw[];
    LAS unsigned char* lds = (LAS unsigned char*)lds_raw;
    cg::grid_group grid = cg::this_grid();
    const int G = gridDim.x, bx = blockIdx.x, NGW = G * NWAVES;
    unsigned bar_target = 0u; (void)bar_target;
    if (threadIdx.x == 0) (void)xb_add((unsigned*)(args.ws + WS_XB) + XB_XCNT(xb_xcc_id()), 1u);
    if (threadIdx.x < 2) ((volatile LAS unsigned*)(lds + 147200))[threadIdx.x] = 0u;
    __syncthreads();
    if (bx == 0 && threadIdx.x == 0) __hip_atomic_store((unsigned*)(args.ws + WS_BAR), 0u, __ATOMIC_RELAXED, __HIP_MEMORY_SCOPE_AGENT);
    if (bx == 0 && threadIdx.x >= 32 && threadIdx.x < 40) __hip_atomic_store((unsigned*)(args.ws + WS_BAR) + threadIdx.x, 0u, __ATOMIC_RELAXED, __HIP_MEMORY_SCOPE_AGENT);
#define PHASE_IDS int tid = threadIdx.x; asm volatile("" : "+v"(tid)); int bxl = bx; asm volatile("" : "+s"(bxl)); const int lane = tid & 63, wave = __builtin_amdgcn_readfirstlane(tid >> 6), gw = bxl * NWAVES + wave; (void)lane; (void)gw;
#define GBAR xcd_barrier((unsigned*)(args.ws + WS_XB), (volatile LAS unsigned*)(lds + 147200))
#define LWS unsigned char* ws = args.ws; asm volatile("" : "+s"(ws));
#define X ((bf16_t*)(ws + WS_X))
#define H ((bf16_t*)(ws + WS_H))
#define ACT ((bf16_t*)(ws + WS_Z))
#define AIN(i) (args.in[opq(i)])
#define CONV_DECODE(itv, lyr) do { int m_ = 0; while (CONV_TAB[m_].end <= (itv)) ++m_; const ConvTab e_ = CONV_TAB[m_]; const int r_ = (itv) - (m_ ? CONV_TAB[m_ - 1].end : 0), nblk_ = (e_.N + 255) >> 8; \
                dsc.W = args.in[e_.idx] + (size_t)(lyr) * e_.K * e_.N; dsc.WT = (bf16_t*)(ws + (size_t)e_.off256 * 256); dsc.K = e_.K; dsc.N = e_.N; dsc.kind = e_.kind; dsc.ldw = e_.ldw; dsc.koff = e_.koff; \
                { const int gi_ = (e_.idx == 6) ? 5 : (e_.idx == 22 || e_.idx == 23) ? 21 : ((e_.idx == 2 || e_.idx == 3) && (lyr) > 0) ? 1 : -1; const float* gp_ = args.in[gi_ < 0 ? 0 : gi_] + (size_t)(lyr) * D; dsc.gain = gi_ < 0 ? nullptr : gp_; } \
                dsc.k0 = 64 * (r_ / nblk_); dsc.n0 = 256 * (r_ % nblk_); } while (0)
#define CONV_RUN(first, last, rank, nranks, lyr) do { \
                LAS float* tile = (LAS float*)lds; \
                ConvDesc dsc{}; f32x4 cv[8]; \
                _Pragma("unroll") for (int r = 0; r < 8; ++r) cv[r] = (f32x4){0.f, 0.f, 0.f, 0.f}; \
                int it = (first) + (rank); \
                if (it < (last)) { CONV_DECODE(it, lyr); conv_load(dsc, wave, lane, cv); } \
                while (it < (last)) { \
                    conv_lds_write(tile, wave, lane, cv); \
                    __syncthreads(); \
                    const ConvDesc cur = dsc; \
                    const int nx = it + (nranks); \
                    if (nx < (last)) { CONV_DECODE(nx, lyr); conv_load(dsc, wave, lane, cv); } \
                    conv_store(cur, tile, tid); \
                    __syncthreads(); \
                    it = nx; \
                } } while (0)

    for (int layer = 0; layer < DEPTH; ++layer) {

        {
            PHASE_IDS LWS
            {
                const int e0 = layer == 0 ? CE2 : CE1;
                CONV_RUN(0, e0, bxl, G, layer);
                CONV_RUN(CE3, CE4, (bxl + G - e0 % G) % G, G, layer);
                CONV_RUN(CE5, CE16, (bxl + G - (e0 + CE4 - CE3) % G) % G, G, layer);
            }
            for (int it = gw; it < 512; it += NGW) { const int kv = it >> 8, kc = (it >> 2) & 63, c = (it & 3) * 64 + lane;
                const float* pos = AIN(kv ? 14 : 11) + (size_t)layer * 4096 + kc * 64; const float* w1 = AIN(kv ? 15 : 12) + (size_t)layer * 4096 * 256 + (size_t)kc * 64 * 256 + c;
                float a = 0.f;
#pragma unroll 8
                for (int k = 0; k < 64; ++k) a += pos[k] * w1[(size_t)k * 256];
                ((float*)(ws + WS_BPART))[(kv * 64 + kc) * 256 + c] = a; }
            if (layer == 0) {
                for (int i = bx * NTHREADS + tid; i < SEQ * 96; i += G * NTHREADS) {
                    const int pos = i / 96, f = i % 96; const bool hd = f < 64; const int fi = hd ? f : f - 64;
                    const float ex = hd ? (float)fi / 64.f : (float)fi / 32.f;
                    const float inv = 1.0f / powf(10000.0f, ex);
                    const float ang = (float)pos * inv;
                    double rv = (double)ang * 0.15915494309189535; rv -= rint(rv);
                    const float fr = (float)rv;
                    const float c = __builtin_amdgcn_cosf(fr), sn = __builtin_amdgcn_sinf(fr);
                    if (hd) { ((float*)(ws + WS_COSH))[pos * 64 + fi] = c; ((float*)(ws + WS_SINH))[pos * 64 + fi] = sn; }
                    else { ((float*)(ws + WS_COSR))[pos * 32 + fi] = c; ((float*)(ws + WS_SINR))[pos * 32 + fi] = sn; }
                }
            }
            const float* ffn1_norm_p = AIN(1) + (size_t)layer * D; const float* x_in = AIN(0);
            if (layer == 0) { for (int m = gw; m < T; m += NGW) rms_row_bf16(x_in + (size_t)m * D, ffn1_norm_p, H + (size_t)m * D, lane); }
        }
        if (args.out == nullptr) grid.sync();
        GBAR;
        { LWS pg8::Gemm g{layer == 0 ? (const bf16_t*)H : (const bf16_t*)X, (const bf16_t*)(ws + WS_GU1), D, D, T, 2 * DFF, D}; pg8::StaticOrder S; S.init(T, 2 * DFF, G, opq(bx));
          pg8::EpiSwiglu E{ACT, DFF, layer == 0 ? (const float*)nullptr : (const float*)(ws + WS_SSP)}; pg8::gemm_phase(lds, g, S, E); }
        { constexpr int full = ((T / 256) * (2 * DFF / 256)) % 256;
          if (G == 256 && bx >= full) { PHASE_IDS LWS CONV_RUN(CE4, CE5, bxl - full, G - full, layer); }
          else if (G != 256) { PHASE_IDS LWS CONV_RUN(CE4, CE5, bxl, G, layer); } }
        GBAR;
        { LWS pg8::Gemm g{ACT, (const bf16_t*)(ws + WS_DN1), DFF, DFF, T, D, DFF}; pg8::StaticOrder S; S.init(T, D, G, opq(bx));
          if (layer == 0) { pg8::EpiResidual<true, 1, (long)WS_SSP - (long)WS_X> E{X, AIN(0)}; pg8::gemm_phase(lds, g, S, E); }
          else { pg8::EpiResidual<false, 1, (long)WS_SSP - (long)WS_X> E{X, nullptr}; pg8::gemm_phase(lds, g, S, E); } }
        GBAR;
        { LWS pg8::Gemm g{X, (const bf16_t*)(ws + WS_WIN), D, D, T, ZW, D}; pg8::StaticOrder S; S.init(T, ZW, G, opq(bx));
          pg8::EpiBf16<0> E{(bf16_t*)(ws + WS_Z), ZW, ZW, nullptr, (const float*)(ws + WS_SSP)}; pg8::gemm_phase(lds, g, S, E); }
        { constexpr int full = ((T / 256) * (ZW / 256)) % 256;
          if (G == 256 && bx >= full) { PHASE_IDS LWS CONV_RUN(CE2, CE3, bxl - full, G - full, layer); }
          else if (G != 256) { PHASE_IDS LWS CONV_RUN(CE2, CE3, bxl, G, layer); } }
        GBAR;
        {
            LWS
            for (int u = bx; u < T / 32; u += G) prep_unit(lds, ws, AIN(7) + (size_t)layer * 512, AIN(9) + (size_t)layer * 256, u);
            if (bx == G - 1) { PHASE_IDS const float* bp = (const float*)(ws + WS_BPART) + (tid >> 8) * 64 * 256 + (tid & 255); float a = 0.f;
                for (int k = 0; k < 64; ++k) a += bp[k * 256];
                ((float*)(ws + WS_BIAS))[tid] = a; }
        }
        GBAR;
        {
            { PHASE_IDS LWS for (int i = bx * NTHREADS + tid; i < 32 * 512; i += G * NTHREADS) { const float* p = (const float*)(ws + WS_KMP) + (size_t)(i >> 9) * 8 * 512 + (i & 511); float a = 0.f;
#pragma unroll
                for (int k = 0; k < 8; ++k) a += p[k * 512];
                ((float*)(ws + WS_KM))[i] = a * (1.f / 256.f); } }
            { LWS pg8::Gemm g{(const bf16_t*)(ws + WS_CQN), (const bf16_t*)(ws + WS_UQ), 512, 512, T, 1280, 512}; pg8::StaticOrder S; S.init(T, 1280, G, opq(bx));
              pg8::EpiBf16<0> E{(bf16_t*)(ws + WS_QF), 1152, 1152, nullptr}; pg8::gemm_phase(lds, g, S, E); }
            { LWS pg8::Gemm g{(const bf16_t*)(ws + WS_CKVN), (const bf16_t*)(ws + WS_UKV), 256, 256, T, 1536, 256}; pg8::StaticOrder S; S.init(T, 1536, G == 256 ? 96 : G, opq(G == 256 ? (bx >= 160 ? bx - 160 : (1 << 20)) : (bx + G - 160 % G) % G));
              pg8::EpiBf16<0> E{(bf16_t*)(ws + WS_KVF), 1536, 1536, nullptr}; pg8::gemm_phase(lds, g, S, E); }
        }
        GBAR;
        {
            int Gl = G; asm volatile("" : "+s"(Gl));
            const int NCMP = 16;
            if (bx < NCMP) {
                PHASE_IDS LWS
                const int kv = bxl >> 3, half = (bxl >> 2) & 1, rtile = bxl & 3;
                unsigned* flag = (unsigned*)(ws + WS_BAR) + 32 + kv * 4 + rtile;
                float* part = (float*)(ws + WS_H1P) + (size_t)kv * 1024 * 256;
                pg8::Gemm g{(const bf16_t*)(ws + (kv ? WS_VCP : WS_KCP)) + half * 2048, (const bf16_t*)(ws + (kv ? WS_W1V : WS_W1K)) + half * 2048, 2048, 4096, 1024, 256, 2048};
                pg8::StaticOrder S; S.init(1024, 256, 4, opq(rtile));
                if (half == 0) {
                    pg8::EpiF32 E{part, 256, 256}; pg8::gemm_phase(lds, g, S, E);
                    asm volatile("s_waitcnt vmcnt(0)" ::: "memory");
                    __syncthreads();
                    if (tid == 0) { __builtin_amdgcn_fence(__ATOMIC_RELEASE, "agent"); asm volatile("s_waitcnt vmcnt(0)" ::: "memory");
                        __hip_atomic_fetch_add(flag, 1u, __ATOMIC_RELAXED, __HIP_MEMORY_SCOPE_AGENT); }
                } else {
                    pg8::EpiCmpFinish E{(bf16_t*)(ws + (kv ? WS_H1V : WS_H1K)), part, (const float*)(ws + WS_BIAS) + kv * 256, flag, (unsigned)(layer + 1)};
                    pg8::gemm_phase(lds, g, S, E);
                    asm volatile("s_waitcnt vmcnt(0)" ::: "memory");
                    __syncthreads();
                    const int rt0 = rtile * 16, r16 = lane & 15, g4 = lane >> 4;
                    for (int wt = wave; wt < 128; wt += NWAVES) { const int rt = rt0 + (wt >> 3), ct = wt & 7;
                        const bf16_t* Ap = (const bf16_t*)(ws + (kv ? WS_H1V : WS_H1K)) + (size_t)(rt * 16 + r16) * 256 + g4 * 8;
                        const bf16_t* Bp = (const bf16_t*)(ws + (kv ? WS_W2V : WS_W2K)) + (size_t)(ct * 16 + r16) * 256 + g4 * 8;
                        f32x4 c = {0.f, 0.f, 0.f, 0.f};
#pragma unroll
                        for (int ks = 0; ks < 8; ++ks) { const bf16x8 a = *(const bf16x8*)(Ap + ks * 32), bq = *(const bf16x8*)(Bp + ks * 32); c = __builtin_amdgcn_mfma_f32_16x16x32_bf16(a, bq, c, 0, 0, 0); }
                        float* op = (float*)(ws + (kv ? WS_VCMP : WS_KCMP)) + (size_t)(rt * 16 + g4 * 4) * 128 + ct * 16 + r16;
#pragma unroll
                        for (int j = 0; j < 4; ++j) op[j * 128] = c[j]; }
                }
            }
            if (bx >= NCMP) {
                LWS
                const int vb = bx - NCMP, VG = G - NCMP;
                for (int r = 0; r * VG < 640; ++r) { const int p = r * VG + ((r & 1) ? VG - 1 - vb : vb);
                    if (p < 640) { const int code = ATT_ORDER.u[p];
                        if (code & 0x1000) att::moba_unit(lds, ws, code & 0xfff); else att::mla_unit(lds, ws, code); } }
            }
        }
        GBAR;
        { LWS
          if (G == 256) { att::nsa_cmp_unit(lds, ws, 2 * bx, true); att::nsa_cmp_unit(lds, ws, 2 * bx + 1, false); }
          else { for (int u = bx; u < 512; u += G) att::nsa_cmp_unit(lds, ws, u, true); } }
        GBAR;
        { LWS for (int r = 0; r * G < 384; ++r) { const int p = r * G + ((r & 1) ? G - 1 - bx : bx); if (p < 384) att::nsa_unit(lds, ws, p); } }
        GBAR;
        { LWS pg8::Gemm g{(const bf16_t*)(ws + WS_YA), (const bf16_t*)(ws + WS_BRA), D, D, T, D, D}; pg8::StaticOrder S; S.init(T, D, G, opq(bx));
          pg8::EpiMergeH E{H, (const bf16_t*)(ws + WS_Z) + Z_MERGE, ZW}; pg8::gemm_phase(lds, g, S, E); }
        GBAR;
        { LWS pg8::Gemm g{H, (const bf16_t*)(ws + WS_WO), D, D, T, D, D}; pg8::StaticOrder S; S.init(T, D, G, opq(bx));
          pg8::EpiResidual<false, 2, (long)WS_SSP - (long)WS_X> E{X, nullptr}; pg8::gemm_phase(lds, g, S, E); }
        GBAR;
        { LWS pg8::Gemm g{X, (const bf16_t*)(ws + WS_GU2), D, D, T, 2 * DFF, D}; pg8::StaticOrder S; S.init(T, 2 * DFF, G, opq(bx));
          pg8::EpiSwiglu E{ACT, DFF, (const float*)(ws + WS_SSP)}; pg8::gemm_phase(lds, g, S, E); }
        if (layer + 1 < DEPTH) { constexpr int full = ((T / 256) * (2 * DFF / 256)) % 256;
          if (G == 256 && bx >= full) { PHASE_IDS LWS CONV_RUN(CE1, CE2, bxl - full, G - full, layer + 1); }
          else if (G != 256) { PHASE_IDS LWS CONV_RUN(CE1, CE2, bxl, G, layer + 1); } }
        GBAR;
        { LWS pg8::Gemm g{ACT, (const bf16_t*)(ws + WS_DN2), DFF, DFF, T, D, DFF}; pg8::StaticOrder S; S.init(T, D, G, opq(bx));
          pg8::EpiResidual<false, 1, (long)WS_SSP - (long)WS_X> E{X, nullptr}; pg8::gemm_phase(lds, g, S, E); }
        GBAR;
    }
    { PHASE_IDS LWS const float* gp = AIN(25); float* outp = args.out; for (int m = gw; m < T; m += NGW) rms_xrow_f32(X + (size_t)m * D, gp, outp + (size_t)m * D, lane); }
}

extern "C" void kernel_launch(void* const* d_in, const int* in_sizes, int n_in, void* d_out, int out_size, void* d_ws, size_t ws_size, hipStream_t stream) {
    static int grid_blocks = 0;
    if (grid_blocks == 0) {
        if (n_in != 26 || ws_size < WS_END0) { fprintf(stderr, "kernel_launch: unexpected n_in %d / ws_size %zu (need %zu)\n", n_in, ws_size, (size_t)WS_END0); grid_blocks = -1; return; }
        int dev = 0, cus = 0, per_cu = 0;
        hipGetDevice(&dev);
        hipDeviceGetAttribute(&cus, hipDeviceAttributeMultiprocessorCount, dev);
        if (hipFuncSetAttribute((const void*)mega_fwd, hipFuncAttributeMaxDynamicSharedMemorySize, LDS_BYTES) != hipSuccess) fprintf(stderr, "kernel_launch: hipFuncSetAttribute failed\n");
        if (hipOccupancyMaxActiveBlocksPerMultiprocessor(&per_cu, (const void*)mega_fwd, NTHREADS, LDS_BYTES) != hipSuccess || per_cu < 1) { fprintf(stderr, "kernel_launch: occupancy query gave %d\n", per_cu); per_cu = 1; }
        (void)hipGetLastError();
        grid_blocks = cus * per_cu;
    }
    if (grid_blocks < 0) return;
    Args a{};
    for (int i = 0; i < 26; ++i) a.in[i] = (const float*)d_in[i];
    a.out = (float*)d_out; a.ws = (unsigned char*)d_ws;
    void* kargs[] = {&a};
    if (hipMemsetAsync((char*)d_ws + WS_XB, 0, 16384, stream) != hipSuccess) fprintf(stderr, "kernel_launch: hipMemsetAsync of the barrier words failed\n");
    hipError_t e = hipLaunchCooperativeKernel((const void*)mega_fwd, dim3(grid_blocks), dim3(NTHREADS), kargs, LDS_BYTES, stream);
    if (e != hipSuccess) fprintf(stderr, "cooperative launch failed: %s (grid %d)\n", hipGetErrorString(e), grid_blocks);
}
```
